# Optimizing an MI355X kernel written in HIP

```python
import jax, jax.numpy as jnp
from jax import lax
import numpy as np

D_MODEL = 1024
BATCH = 8
SEQ = 2048
DEPTH = 2
DEC_BATCH = 128
DEC_SEQ = 4
PAST_LEN = 16384
PAGE_SIZE = 128

N_HEADS = 8
HEAD_K = 128
HEAD_V = 128
QK_W = N_HEADS * HEAD_K
V_W = N_HEADS * HEAD_V
CONV_W = 4
CONV_CH = 2 * QK_W + V_W
CHUNK = 64
POOL_GROUPS = 4
POOL_WINDOWS = (2, 4, 8, 16)
POOL_W = D_MODEL
POOL_GC = POOL_W // POOL_GROUPS
POOL_HIST = max(POOL_WINDOWS) - 1
PLE_DIM = 256
IN_SIZES = (QK_W, QK_W, V_W, V_W, N_HEADS, N_HEADS, POOL_W, POOL_W, D_MODEL, D_MODEL)
IN_W = sum(IN_SIZES)
IN_SPLITS = tuple(int(s) for s in np.cumsum(IN_SIZES)[:-1])
EPS = 1e-6

kernel_name = 'hybrid_gdn_pool_decoder_step'


def rmsnorm(x, w):
    xf = x.astype(jnp.float32)
    y = xf * lax.rsqrt(jnp.mean(xf * xf, axis=-1, keepdims=True) + EPS)
    return (y * w.astype(jnp.float32)).astype(x.dtype)


def l2norm(x):
    xf = x.astype(jnp.float32)
    return xf * lax.rsqrt(jnp.sum(xf * xf, axis=-1, keepdims=True) + EPS)


def causal_conv(xc, hist, w):
    full = jnp.concatenate([hist.astype(xc.dtype), xc], axis=1)
    T = xc.shape[1]
    out = full[:, 0:T] * w[0]
    for j in range(1, CONV_W):
        out = out + full[:, j:j + T] * w[j]
    return jax.nn.silu(out), full[:, -(CONV_W - 1):]


def gated_delta_chunked(q, k, v, g, beta, s0, chunk):
    B, T, H, K = q.shape
    V = v.shape[-1]
    n = T // chunk

    def blk(t):
        t = t.reshape((B, n, chunk, H) + t.shape[3:])
        return jnp.moveaxis(t, 3, 1)

    qc, kc, vc, gc, bc = blk(q), blk(k), blk(v), blk(g), blk(beta)
    G = jnp.cumsum(gc, axis=-1)
    idx = jnp.arange(chunk)
    lower = idx[:, None] >= idx[None, :]
    strict = idx[:, None] > idx[None, :]
    decay = jnp.exp(jnp.where(lower, G[..., :, None] - G[..., None, :], -jnp.inf))
    kk = jnp.einsum('bhnik,bhnjk->bhnij', kc, kc)
    a_mat = jnp.where(strict, kk * decay * bc[..., :, None], 0.0)
    eye = jnp.eye(chunk, dtype=jnp.float32)
    rhs = jnp.concatenate([vc * bc[..., None], kc * (bc * jnp.exp(G))[..., None]], axis=-1)
    sol = lax.linalg.triangular_solve(eye + a_mat, rhs, left_side=True, lower=True)
    w_val, w_key = sol[..., :V], sol[..., V:]
    qk = jnp.einsum('bhnik,bhnjk->bhnij', qc, kc) * decay
    q_dec = qc * jnp.exp(G)[..., None]
    k_tail = kc * jnp.exp(G[..., -1:] - G)[..., None]
    g_last = jnp.exp(G[..., -1])

    def step(s, xs):
        wv, wk, qk_i, qd, kt, gl = xs
        u = wv - jnp.einsum('bhck,bhkv->bhcv', wk, s)
        o = jnp.einsum('bhck,bhkv->bhcv', qd, s) + jnp.einsum('bhij,bhjv->bhiv', qk_i, u)
        s = s * gl[..., None, None] + jnp.einsum('bhck,bhcv->bhkv', kt, u)
        return s, o

    xs = tuple(jnp.moveaxis(t, 2, 0) for t in (w_val, w_key, qk, q_dec, k_tail, g_last))
    s_fin, o = lax.scan(step, s0, xs)
    o = jnp.transpose(o, (1, 0, 3, 2, 4)).reshape(B, T, H, V)
    return o, s_fin


def pool_mix(u, hist, pos0, w_grp, scale):
    B, T, _ = u.shape
    full = jnp.concatenate([hist.astype(u.dtype), u], axis=1)
    cs = jnp.cumsum(full.astype(jnp.float32), axis=1)
    cs = jnp.concatenate([jnp.zeros_like(cs[:, :1]), cs], axis=1)
    cs = cs.reshape(B, POOL_HIST + T + 1, POOL_GROUPS, POOL_GC)
    win = jnp.array(POOL_WINDOWS, dtype=jnp.int32)
    t = jnp.arange(T, dtype=jnp.int32)
    lo = (POOL_HIST + 1 + t)[:, None] - win[None, :]
    cs_hi = cs[:, POOL_HIST + 1:]
    cs_lo = cs[:, lo, jnp.arange(POOL_GROUPS)[None, :]]
    count = jnp.minimum((pos0 + 1 + t)[:, None], win[None, :]).astype(jnp.float32)
    ug = u.astype(jnp.float32).reshape(B, T, POOL_GROUPS, POOL_GC)
    y = (cs_hi - cs_lo) / count[None, :, :, None] - ug
    y = jnp.einsum('btgc,gcd->btgd', y, w_grp.astype(jnp.float32)).reshape(B, T, POOL_W)
    y = y * scale.astype(jnp.float32)
    return y.astype(u.dtype), full[:, -POOL_HIST:]


def mixer_layer(x, p_i, conv_hist, s0, pool_hist, pos0, norm_mix, w_in, conv_w, a_log, dt_bias, gdn_norm,
                w_proj_a, pool_w, pool_scale, w_proj_b, w_out, norm_ple, w_ple_gate, w_ple_proj):
    B, T, _ = x.shape
    h = rmsnorm(x, norm_mix)
    proj = h @ w_in
    q_r, k_r, v_r, z, a_r, b_r, u, gp, ga, gb = jnp.split(proj, IN_SPLITS, axis=-1)
    qkv, conv_new = causal_conv(jnp.concatenate([q_r, k_r, v_r], axis=-1), conv_hist, conv_w)
    q, k, v = jnp.split(qkv, (QK_W, 2 * QK_W), axis=-1)
    q = l2norm(q.reshape(B, T, N_HEADS, HEAD_K)) * (HEAD_K ** -0.5)
    k = l2norm(k.reshape(B, T, N_HEADS, HEAD_K))
    v = v.reshape(B, T, N_HEADS, HEAD_V).astype(jnp.float32)
    g = -jnp.exp(a_log.astype(jnp.float32)) * jax.nn.softplus(a_r.astype(jnp.float32) + dt_bias.astype(jnp.float32))
    beta = jax.nn.sigmoid(b_r.astype(jnp.float32))
    chunk = CHUNK if T % CHUNK == 0 else T
    o, s_new = gated_delta_chunked(q, k, v, g, beta, s0.astype(jnp.float32), chunk)
    o = rmsnorm(o, gdn_norm).astype(x.dtype) * jax.nn.silu(z.reshape(B, T, N_HEADS, HEAD_V))
    y_a = o.reshape(B, T, V_W) @ w_proj_a
    y_pool, pool_new = pool_mix(u, pool_hist, pos0, pool_w, pool_scale)
    y_b = (y_pool * jax.nn.silu(gp)) @ w_proj_b
    m = jax.nn.sigmoid(ga) * y_a + jax.nn.sigmoid(gb) * y_b
    x = x + m @ w_out
    x = x + jax.nn.sigmoid(rmsnorm(x, norm_ple) @ w_ple_gate) * (p_i @ w_ple_proj)
    return x, conv_new, s_new.astype(x.dtype), pool_new


def run_group(x, p, conv_state, delta_state, pool_state, pos0, norm_mix, w_in, conv_w, a_log, dt_bias, gdn_norm,
              w_proj_a, pool_w, pool_scale, w_proj_b, w_out, norm_ple, w_ple_gate, w_ple_proj, final_norm):
    B = x.shape[0]
    convs, deltas, pools = [], [], []
    for i in range(DEPTH):
        if conv_state is None:
            ch = jnp.zeros((B, CONV_W - 1, CONV_CH), x.dtype)
            s0 = jnp.zeros((B, N_HEADS, HEAD_K, HEAD_V), jnp.float32)
            ph = jnp.zeros((B, POOL_HIST, POOL_W), x.dtype)
        else:
            ch, s0, ph = conv_state[i], delta_state[i], pool_state[i]
        x, c_new, s_new, p_new = mixer_layer(
            x, p[i], ch, s0, ph, pos0, norm_mix[i], w_in[i], conv_w[i], a_log[i], dt_bias[i], gdn_norm[i],
            w_proj_a[i], pool_w[i], pool_scale[i], w_proj_b[i], w_out[i], norm_ple[i], w_ple_gate[i], w_ple_proj[i])
        convs.append(c_new)
        deltas.append(s_new)
        pools.append(p_new)
    y = rmsnorm(x, final_norm)
    return y, jnp.stack(convs), jnp.stack(deltas), jnp.stack(pools)


def setup_inputs(seed: int = 0) -> dict:
    key = jax.random.key(seed)
    ks = jax.random.split(key, 24)
    f32 = jnp.float32
    nrm = lambda k, shape, s: (jax.random.normal(k, shape, f32) * s)
    dt = jnp.exp(jax.random.uniform(ks[9], (DEPTH, N_HEADS), f32, np.log(1e-3), np.log(1e-1)))
    return {
        'x_prompt': nrm(ks[0], (BATCH, SEQ, D_MODEL), 1.0),
        'x_sample': nrm(ks[1], (DEC_BATCH, DEC_SEQ, D_MODEL), 1.0),
        'p_prompt': nrm(ks[2], (DEPTH, BATCH, SEQ, PLE_DIM), 1.0),
        'p_sample': nrm(ks[3], (DEPTH, DEC_BATCH, DEC_SEQ, PLE_DIM), 1.0),
        'state_conv': nrm(ks[4], (DEPTH, DEC_BATCH, CONV_W - 1, CONV_CH), 1.0),
        'state_delta': nrm(ks[5], (DEPTH, DEC_BATCH, N_HEADS, HEAD_K, HEAD_V), HEAD_K ** -0.5),
        'state_pool': nrm(ks[6], (DEPTH, DEC_BATCH, POOL_HIST, POOL_W), 1.0),
        'norm_mix': 1.0 + nrm(ks[7], (DEPTH, D_MODEL), 0.02),
        'w_in': nrm(ks[8], (DEPTH, D_MODEL, IN_W), D_MODEL ** -0.5),
        'conv_w': nrm(ks[10], (DEPTH, CONV_W, CONV_CH), 0.5),
        'a_log': jnp.log(jax.random.uniform(ks[11], (DEPTH, N_HEADS), f32, 1.0, 16.0)),
        'dt_bias': dt + jnp.log(-jnp.expm1(-dt)),
        'gdn_norm': 1.0 + nrm(ks[12], (DEPTH, HEAD_V), 0.02),
        'w_proj_a': nrm(ks[13], (DEPTH, V_W, D_MODEL), V_W ** -0.5),
        'pool_w': nrm(ks[14], (DEPTH, POOL_GROUPS, POOL_GC, POOL_GC), POOL_GC ** -0.5),
        'pool_scale': 1.0 + nrm(ks[15], (DEPTH, POOL_W), 0.1),
        'w_proj_b': nrm(ks[16], (DEPTH, POOL_W, D_MODEL), POOL_W ** -0.5),
        'w_out': nrm(ks[17], (DEPTH, D_MODEL, D_MODEL), D_MODEL ** -0.5),
        'norm_ple': 1.0 + nrm(ks[18], (DEPTH, D_MODEL), 0.02),
        'w_ple_gate': nrm(ks[19], (DEPTH, D_MODEL, D_MODEL), D_MODEL ** -0.5),
        'w_ple_proj': nrm(ks[20], (DEPTH, PLE_DIM, D_MODEL), PLE_DIM ** -0.5),
        'final_norm': 1.0 + nrm(ks[21], (D_MODEL,), 0.02),
    }


def reference(x_prompt, x_sample, p_prompt, p_sample, state_conv, state_delta, state_pool, norm_mix, w_in, conv_w,
              a_log, dt_bias, gdn_norm, w_proj_a, pool_w, pool_scale, w_proj_b, w_out, norm_ple, w_ple_gate,
              w_ple_proj, final_norm):
    y_prompt, conv_p, delta_p, pool_p = run_group(
        x_prompt, p_prompt, None, None, None, 0, norm_mix, w_in, conv_w, a_log, dt_bias, gdn_norm, w_proj_a,
        pool_w, pool_scale, w_proj_b, w_out, norm_ple, w_ple_gate, w_ple_proj, final_norm)
    y_sample, conv_s, delta_s, pool_s = run_group(
        x_sample, p_sample, state_conv, state_delta, state_pool, PAST_LEN, norm_mix, w_in, conv_w, a_log, dt_bias,
        gdn_norm, w_proj_a, pool_w, pool_scale, w_proj_b, w_out, norm_ple, w_ple_gate, w_ple_proj, final_norm)
    return (y_prompt, y_sample, conv_p, delta_p, pool_p, conv_s, delta_s, pool_s)
```

```cpp
#include <hip/hip_runtime.h>
#include <hip/hip_cooperative_groups.h>
#include <cstdio>
namespace cg = cooperative_groups;

typedef unsigned short u16;
using bf16x8 = __attribute__((ext_vector_type(8))) short;
using f32x4 = __attribute__((ext_vector_type(4))) float;
typedef __bf16 bf16x2_t __attribute__((ext_vector_type(2)));
typedef float f32x2_t __attribute__((ext_vector_type(2)));
#define DI __device__ __forceinline__

#ifndef REPEAT_KIND
#define REPEAT_KIND -1
#endif
#ifndef ONE_LAUNCH
#define ONE_LAUNCH 1
#endif

constexpr int NT = 256;
constexpr int TP = 16384, TS = 512, T = TP + TS;
constexpr int D = 1024, INW = 8208;
constexpr float EPS = 1e-6f;

constexpr size_t SLOT = (size_t)T * 1024 * 2;
constexpr size_t OFF_WIN = 0;
constexpr size_t OFF_WA = OFF_WIN + (size_t)2 * 8192 * 1024 * 2;
constexpr size_t OFF_WB = OFF_WA + (size_t)2 * 1024 * 1024 * 2;
constexpr size_t OFF_WO = OFF_WB + (size_t)2 * 1024 * 1024 * 2;
constexpr size_t OFF_WG = OFF_WO + (size_t)2 * 1024 * 1024 * 2;
constexpr size_t OFF_WP = OFF_WG + (size_t)2 * 1024 * 1024 * 2;
constexpr size_t OFF_WPL = OFF_WP + (size_t)2 * 1024 * 256 * 2;
constexpr size_t OFF_PB = OFF_WPL + (size_t)2 * 4 * 256 * 256 * 2;
constexpr size_t OFF_G = OFF_PB + (size_t)T * 256 * 2;
constexpr size_t OFF_BETA = OFF_G + (size_t)T * 8 * 4;
constexpr size_t OFF_SSQ = OFF_BETA + (size_t)T * 8 * 4;
constexpr size_t OFF_BAR = OFF_SSQ + (size_t)T * 16 * 4;
constexpr size_t OFF_CNT = OFF_BAR + 14336;
constexpr size_t ZERO_BYTES = 14336 + 256;
constexpr size_t OFF_GL = OFF_CNT + 256;
constexpr size_t OFF_P1 = OFF_GL + 2048 * 4;
constexpr size_t OFF_U = OFF_P1 + 3 * SLOT;
constexpr size_t OFF_EXT = OFF_U + SLOT;
constexpr size_t IMG_BYTES = 57344;
constexpr size_t OFF_IMG = OFF_P1;
constexpr size_t OFF_WVT = OFF_IMG + 2048 * IMG_BYTES;
constexpr size_t OFF_H = OFF_EXT + (2048 * IMG_BYTES + 2048 * 16384 - 4 * SLOT) + 256;
constexpr size_t OFF_Z = OFF_H + SLOT;
constexpr size_t OFF_GP = OFF_Z + SLOT;
constexpr size_t OFF_GA = OFF_GP + SLOT;
constexpr size_t OFF_GB = OFF_GA + SLOT;
constexpr size_t OFF_QA = OFF_GB + SLOT;
constexpr size_t OFF_KA = OFF_QA + SLOT;
constexpr size_t OFF_VA = OFF_KA + SLOT;
constexpr size_t OFF_Y = OFF_VA + SLOT;
constexpr size_t WS_TOTAL = OFF_Y + SLOT;
constexpr size_t OFF_OG = OFF_P1, OFF_M = OFF_P1 + 2 * SLOT, OFF_ORAW = OFF_H, OFF_KT = OFF_H;
constexpr size_t OFF_YB_P = OFF_QA, OFF_YB_S = OFF_VA, OFF_PP_P = OFF_KA, OFF_PP_S = OFF_VA + (size_t)TS * 1024 * 2;

constexpr size_t O_Y = 0;
constexpr size_t O_CONVP = (size_t)T * 1024;
constexpr size_t O_DELTAP = O_CONVP + (size_t)2 * 8 * 3 * 3072;
constexpr size_t O_POOLP = O_DELTAP + (size_t)2 * 8 * 8 * 128 * 128;
constexpr size_t O_CONVS = O_POOLP + (size_t)2 * 8 * 15 * 1024;
constexpr size_t O_DELTAS = O_CONVS + (size_t)2 * 128 * 3 * 3072;
constexpr size_t O_POOLS = O_DELTAS + (size_t)2 * 128 * 8 * 128 * 128;

DI u16* ybin_row(char* ws, size_t t) { return reinterpret_cast<u16*>(ws + (t < (size_t)TP ? OFF_YB_P + t * 2048 : OFF_YB_S + (t - TP) * 2048)); }
DI u16* pp_row(char* ws, size_t t) { return reinterpret_cast<u16*>(ws + (t < (size_t)TP ? OFF_PP_P + t * 2048 : OFF_PP_S + (t - TP) * 2048)); }
struct Params {
  const float *x_prompt, *x_sample, *p_prompt, *p_sample, *state_conv, *state_delta, *state_pool, *norm_mix, *w_in,
      *conv_w, *a_log, *dt_bias, *gdn_norm, *w_proj_a, *pool_w, *pool_scale, *w_proj_b, *w_out, *norm_ple, *w_ple_gate,
      *w_ple_proj, *final_norm;
  float* out;
  char* ws;
  int ph_lo, ph_hi;
};

DI unsigned pk2(float a, float b) {
  f32x2_t v = {a, b};
  bf16x2_t r = __builtin_convertvector(v, bf16x2_t);
  return __builtin_bit_cast(unsigned, r);
}
DI float bflo(unsigned u) { return __uint_as_float(u << 16); }
DI float bfhi(unsigned u) { return __uint_as_float(u & 0xffff0000u); }
DI float frcp_(float x) { return __builtin_amdgcn_rcpf(x); }
DI float sigmoidf_(float x) { return frcp_(1.f + __expf(-x)); }
DI float siluf_(float x) { return x * frcp_(1.f + __expf(-x)); }
DI float wave_sum(float v) {
#pragma unroll
  for (int o = 32; o >= 1; o >>= 1) v += __shfl_xor(v, o);
  return v;
}

DI int lds_off(int r, int c) {
  int st = (r >> 4) * 2 + (c >> 5), rr = r & 15, cc = c & 31, ob = rr * 64 + cc * 2;
  return st * 1024 + (ob ^ (((ob >> 9) & 1) << 5));
}

#define XB_TMO      128
#define XB_XCNT(j)  (256  + 64 * (j))
#define XB_XSUB(j)  (1280 + 64 * (j))
#define XB_XGEN(j)  (2304 + 64 * (j))
#define XB_TOP      3328
#define XB_TOPGEN   3392
#define XB_SPIN_CAP (1u << 20)
#define LAS __attribute__((address_space(3)))
DI unsigned xb_ld(unsigned* p) { return __hip_atomic_load(p, __ATOMIC_RELAXED, __HIP_MEMORY_SCOPE_AGENT); }
DI unsigned xb_add(unsigned* p, unsigned v) { return __hip_atomic_fetch_add(p, v, __ATOMIC_RELAXED, __HIP_MEMORY_SCOPE_AGENT); }
DI unsigned xb_xcc_id() { return (unsigned)__builtin_amdgcn_s_getreg((3 << 11) | 20) & 0xFu; }
#define XB_SPIN(cond, bar) do { unsigned _sp = 0; while (cond) { __builtin_amdgcn_s_sleep(1); \
    if ((++_sp & 255u) == 0u) { if (xb_ld(&(bar)[XB_TMO])) break; if (_sp > XB_SPIN_CAP) { atomicAdd(&(bar)[XB_TMO], 1u); break; } } } } while (0)
struct XcdBarrier { unsigned* bar; unsigned x; volatile LAS unsigned* st; };
DI XcdBarrier xcd_barrier_post(unsigned* bar, volatile LAS unsigned* st) {
  XcdBarrier b; b.bar = bar; b.x = xb_xcc_id(); b.st = st;
  if (threadIdx.x == 0) (void)xb_add(&bar[XB_XCNT(b.x)], 1u);
  return b;
}
DI void xcd_barrier_complete(unsigned* bar, unsigned x, unsigned& nloc, unsigned& nx) {
  const unsigned G = gridDim.x * gridDim.y * gridDim.z;
  unsigned sum, cnt, mine, sp = 0u;
  for (;;) {
    sum = 0u; cnt = 0u; mine = 0u;
#pragma unroll
    for (unsigned j = 0; j < 16; ++j) { const unsigned c = xb_ld(&bar[XB_XCNT(j)]); sum += c; cnt += (c > 0u) ? 1u : 0u; mine = (j == x) ? c : mine; }
    if (sum == G) break;
    __builtin_amdgcn_s_sleep(1);
    if ((++sp & 255u) == 0u) { if (xb_ld(&bar[XB_TMO])) break; if (sp > XB_SPIN_CAP) { atomicAdd(&bar[XB_TMO], 1u); break; } }
  }
  nloc = mine > 0u ? mine : 1u; nx = cnt > 0u ? cnt : 1u;
}
DI void xcd_barrier(const XcdBarrier& b) {
  asm volatile("s_waitcnt vmcnt(0)" ::: "memory");
  __syncthreads();
  if (threadIdx.x == 0) {
    unsigned* bar = b.bar;
    __builtin_amdgcn_s_waitcnt(0);
    unsigned nloc = b.st[0], nx = b.st[1];
    if (nloc == 0u) { xcd_barrier_complete(bar, b.x, nloc, nx); b.st[0] = nloc; b.st[1] = nx; }
    const unsigned old = xb_add(&bar[XB_XSUB(b.x)], 1u);
    const unsigned gen = old / nloc;
    if (old + 1u == (gen + 1u) * nloc) {
      __builtin_amdgcn_fence(__ATOMIC_RELEASE, "agent");
      asm volatile("s_waitcnt vmcnt(0)" ::: "memory");
      const unsigned og = xb_add(&bar[XB_TOP], 1u);
      const unsigned tg = og / nx;
      if (og + 1u == (tg + 1u) * nx) xb_add(&bar[XB_TOPGEN], 1u);
      else XB_SPIN(xb_ld(&bar[XB_TOPGEN]) == tg, bar);
      __builtin_amdgcn_fence(__ATOMIC_ACQUIRE, "agent");
      xb_add(&bar[XB_XGEN(b.x)], 1u);
      asm volatile("s_waitcnt vmcnt(0)" ::: "memory");
    } else {
      XB_SPIN(xb_ld(&bar[XB_XGEN(b.x)]) == gen, bar);
      __builtin_amdgcn_fence(__ATOMIC_ACQUIRE, "agent");
      asm volatile("s_waitcnt vmcnt(0)" ::: "memory");
    }
  }
  __syncthreads();
}

DI void gemm_kloop(const u16* __restrict__ A, size_t lda, const u16* __restrict__ Bt, size_t ldb, int K,
                   f32x4 (&acc)[4][4], char* sm, int tid) {
  const int lane = tid & 63, wave = __builtin_amdgcn_readfirstlane(tid >> 6), wm = wave >> 1, wn = wave & 1;
  const int lr = tid >> 2, lkc = tid & 3;
  const u16* Ap = A + (size_t)lr * lda + lkc * 8;
  const u16* Bp = Bt + (size_t)lr * ldb + lkc * 8;
  const int woff0 = lds_off(lr, lkc * 8), woff1 = lds_off(lr + 64, lkc * 8), woff2 = lds_off(lr, 32 + lkc * 8),
            woff3 = lds_off(lr + 64, 32 + lkc * 8);
  int aoff[4][2], boff[4][2];
#pragma unroll
  for (int m = 0; m < 4; ++m)
#pragma unroll
    for (int kk = 0; kk < 2; ++kk) {
      aoff[m][kk] = lds_off(wm * 64 + m * 16 + (lane & 15), kk * 32 + (lane >> 4) * 8);
      boff[m][kk] = lds_off(wn * 64 + m * 16 + (lane & 15), kk * 32 + (lane >> 4) * 8);
    }
  const int nk = K >> 6;
  uint4 pa0, pa1, pa2, pa3, pb0, pb1, pb2, pb3;
  uint4 qa0, qa1, qa2, qa3, qb0, qb1, qb2, qb3;
#define G_LOAD(S, KT)                                                                        \
  {                                                                                          \
    S##a0 = *reinterpret_cast<const uint4*>(Ap + (KT) * 64);                                 \
    S##a1 = *reinterpret_cast<const uint4*>(Ap + (size_t)64 * lda + (KT) * 64);              \
    S##a2 = *reinterpret_cast<const uint4*>(Ap + (KT) * 64 + 32);                            \
    S##a3 = *reinterpret_cast<const uint4*>(Ap + (size_t)64 * lda + (KT) * 64 + 32);         \
    S##b0 = *reinterpret_cast<const uint4*>(Bp + (KT) * 64);                                 \
    S##b1 = *reinterpret_cast<const uint4*>(Bp + (size_t)64 * ldb + (KT) * 64);              \
    S##b2 = *reinterpret_cast<const uint4*>(Bp + (KT) * 64 + 32);                            \
    S##b3 = *reinterpret_cast<const uint4*>(Bp + (size_t)64 * ldb + (KT) * 64 + 32);         \
  }
#define G_STORE(S, BUF)                                                                      \
  {                                                                                          \
    char* da_ = sm + (BUF) * 16384;                                                          \
    *reinterpret_cast<uint4*>(da_ + woff0) = S##a0;                                          \
    *reinterpret_cast<uint4*>(da_ + woff1) = S##a1;                                          \
    *reinterpret_cast<uint4*>(da_ + woff2) = S##a2;                                          \
    *reinterpret_cast<uint4*>(da_ + woff3) = S##a3;                                          \
    *reinterpret_cast<uint4*>(da_ + 32768 + woff0) = S##b0;                                  \
    *reinterpret_cast<uint4*>(da_ + 32768 + woff1) = S##b1;                                  \
    *reinterpret_cast<uint4*>(da_ + 32768 + woff2) = S##b2;                                  \
    *reinterpret_cast<uint4*>(da_ + 32768 + woff3) = S##b3;                                  \
  }
#define G_COMPUTE(BUF)                                                                       \
  {                                                                                          \
    const char* sa = sm + (BUF) * 16384;                                                     \
    const char* sb = sm + 32768 + (BUF) * 16384;                                             \
    _Pragma("unroll") for (int kk = 0; kk < 2; ++kk) {                                       \
      bf16x8 af[4], bfr[4];                                                                  \
      _Pragma("unroll") for (int m = 0; m < 4; ++m) af[m] = *reinterpret_cast<const bf16x8*>(sa + aoff[m][kk]);  \
      _Pragma("unroll") for (int n = 0; n < 4; ++n) bfr[n] = *reinterpret_cast<const bf16x8*>(sb + boff[n][kk]); \
      _Pragma("unroll") for (int m = 0; m < 4; ++m)                                          \
        _Pragma("unroll") for (int n = 0; n < 4; ++n)                                        \
          acc[m][n] = __builtin_amdgcn_mfma_f32_16x16x32_bf16(bfr[n], af[m], acc[m][n], 0, 0, 0);                \
    }                                                                                        \
  }
  const int nkm1 = nk - 1;
  G_LOAD(p, 0)
  G_STORE(p, 0)
  G_LOAD(p, 1)
  __builtin_amdgcn_sched_barrier(0);
  G_LOAD(q, min(2, nkm1))
  __builtin_amdgcn_sched_barrier(0);
  __syncthreads();
  for (int kt = 0; kt < nk; kt += 2) {
    G_COMPUTE(0)
    G_STORE(p, 1)
    G_LOAD(p, min(kt + 3, nkm1))
    __syncthreads();
    G_COMPUTE(1)
    G_STORE(q, 0)
    G_LOAD(q, min(kt + 4, nkm1))
    __syncthreads();
  }
}

#define GREGS_DECL uint4 g_pa0, g_pa1, g_pa2, g_pa3, g_pb0, g_pb1, g_pb2, g_pb3, g_qa0, g_qa1, g_qa2, g_qa3, g_qb0, g_qb1, g_qb2, g_qb3
#define GREGS_PARAMS uint4 &g_pa0, uint4 &g_pa1, uint4 &g_pa2, uint4 &g_pa3, uint4 &g_pb0, uint4 &g_pb1, uint4 &g_pb2, uint4 &g_pb3, uint4 &g_qa0, uint4 &g_qa1, uint4 &g_qa2, uint4 &g_qa3, uint4 &g_qb0, uint4 &g_qb1, uint4 &g_qb2, uint4 &g_qb3
#define GREGS_ARGS g_pa0, g_pa1, g_pa2, g_pa3, g_pb0, g_pb1, g_pb2, g_pb3, g_qa0, g_qa1, g_qa2, g_qa3, g_qb0, g_qb1, g_qb2, g_qb3
DI void gemm_stream(const u16* __restrict__ A, const u16* __restrict__ Bt, const u16* __restrict__ An,
                    const u16* __restrict__ Btn, size_t lda, size_t ldb, int K, bool first, f32x4 (&acc)[4][4], GREGS_PARAMS,
                    char* sm, int tid) {
  const int lane = tid & 63, wave = __builtin_amdgcn_readfirstlane(tid >> 6), wm = wave >> 1, wn = wave & 1;
  const int lr = tid >> 2, lkc = tid & 3;
  const u16* Ap = A + (size_t)lr * lda + lkc * 8;
  const u16* Bp = Bt + (size_t)lr * ldb + lkc * 8;
  const u16* Apn = An + (size_t)lr * lda + lkc * 8;
  const u16* Bpn = Btn + (size_t)lr * ldb + lkc * 8;
  const int woff0 = lds_off(lr, lkc * 8), woff1 = lds_off(lr + 64, lkc * 8), woff2 = lds_off(lr, 32 + lkc * 8),
            woff3 = lds_off(lr + 64, 32 + lkc * 8);
  int aoff[4][2], boff[4][2];
#pragma unroll
  for (int m = 0; m < 4; ++m)
#pragma unroll
    for (int kk = 0; kk < 2; ++kk) {
      aoff[m][kk] = lds_off(wm * 64 + m * 16 + (lane & 15), kk * 32 + (lane >> 4) * 8);
      boff[m][kk] = lds_off(wn * 64 + m * 16 + (lane & 15), kk * 32 + (lane >> 4) * 8);
    }
  const int nk = K >> 6;
#define S_LOAD(S, IDX)                                                                       \
  {                                                                                          \
    const int ix_ = (IDX);                                                                   \
    const u16* a_ = ix_ < nk ? Ap + ix_ * 64 : Apn + (ix_ - nk) * 64;                        \
    const u16* b_ = ix_ < nk ? Bp + ix_ * 64 : Bpn + (ix_ - nk) * 64;                        \
    g_##S##a0 = *reinterpret_cast<const uint4*>(a_);                                           \
    g_##S##a1 = *reinterpret_cast<const uint4*>(a_ + (size_t)64 * lda);                        \
    g_##S##a2 = *reinterpret_cast<const uint4*>(a_ + 32);                                      \
    g_##S##a3 = *reinterpret_cast<const uint4*>(a_ + (size_t)64 * lda + 32);                   \
    g_##S##b0 = *reinterpret_cast<const uint4*>(b_);                                           \
    g_##S##b1 = *reinterpret_cast<const uint4*>(b_ + (size_t)64 * ldb);                        \
    g_##S##b2 = *reinterpret_cast<const uint4*>(b_ + 32);                                      \
    g_##S##b3 = *reinterpret_cast<const uint4*>(b_ + (size_t)64 * ldb + 32);                   \
  }
#define S_STORE(S, BUF)                                                                      \
  {                                                                                          \
    char* da_ = sm + (BUF) * 16384;                                                          \
    *reinterpret_cast<uint4*>(da_ + woff0) = g_##S##a0;                                        \
    *reinterpret_cast<uint4*>(da_ + woff1) = g_##S##a1;                                        \
    *reinterpret_cast<uint4*>(da_ + woff2) = g_##S##a2;                                        \
    *reinterpret_cast<uint4*>(da_ + woff3) = g_##S##a3;                                        \
    *reinterpret_cast<uint4*>(da_ + 32768 + woff0) = g_##S##b0;                                \
    *reinterpret_cast<uint4*>(da_ + 32768 + woff1) = g_##S##b1;                                \
    *reinterpret_cast<uint4*>(da_ + 32768 + woff2) = g_##S##b2;                                \
    *reinterpret_cast<uint4*>(da_ + 32768 + woff3) = g_##S##b3;                                \
  }
  if (first) {
    S_LOAD(p, 0)
    S_STORE(p, 0)
    S_LOAD(p, 1)
    __builtin_amdgcn_sched_barrier(0);
    S_LOAD(q, 2)
    __builtin_amdgcn_sched_barrier(0);
    __syncthreads();
  }
  for (int kt = 0; kt < nk; kt += 2) {
    G_COMPUTE(0)
    S_STORE(p, 1)
    S_LOAD(p, kt + 3)
    __syncthreads();
    G_COMPUTE(1)
    S_STORE(q, 0)
    S_LOAD(q, kt + 4)
    __syncthreads();
  }
}

DI void glds16(const u16* g, char* l) {
  __builtin_amdgcn_global_load_lds(reinterpret_cast<const unsigned*>(g), reinterpret_cast<unsigned*>(l), 16, 0, 0);
}
DI void gemm_dma(const u16* __restrict__ A, const u16* __restrict__ Bt, const u16* __restrict__ An,
                 const u16* __restrict__ Btn, size_t lda, size_t ldb, int K, bool first, f32x4 (&acc)[4][4], char* sm,
                 int tid) {
  const int lane = tid & 63, wave = __builtin_amdgcn_readfirstlane(tid >> 6), wm = wave >> 1, wn = wave & 1;
  const int sb = lane * 16, swz = sb ^ (((sb >> 9) & 1) << 5);
  const int R0 = (wave >> 1) * 16 + (swz >> 6), C = (wave & 1) * 32 + ((swz & 63) >> 1);
  const u16* Ap = A + (size_t)R0 * lda + C;
  const u16* Bp = Bt + (size_t)R0 * ldb + C;
  const u16* Apn = An + (size_t)R0 * lda + C;
  const u16* Bpn = Btn + (size_t)R0 * ldb + C;
  char* l0 = sm + tid * 16;
  int aoff[4][2], boff[4][2];
#pragma unroll
  for (int m = 0; m < 4; ++m)
#pragma unroll
    for (int kk = 0; kk < 2; ++kk) {
      aoff[m][kk] = lds_off(wm * 64 + m * 16 + (lane & 15), kk * 32 + (lane >> 4) * 8);
      boff[m][kk] = lds_off(wn * 64 + m * 16 + (lane & 15), kk * 32 + (lane >> 4) * 8);
    }
  const int nk = K >> 6;
#define D_LOAD(IDX, BUF)                                                                     \
  {                                                                                          \
    const int ix_ = (IDX);                                                                   \
    const u16* a_ = ix_ < nk ? Ap + ix_ * 64 : Apn;                                          \
    const u16* b_ = ix_ < nk ? Bp + ix_ * 64 : Bpn;                                          \
    char* la_ = l0 + (BUF) * 16384;                                                          \
    glds16(a_, la_);                                                                         \
    glds16(a_ + (size_t)32 * lda, la_ + 4096);                                               \
    glds16(a_ + (size_t)64 * lda, la_ + 8192);                                               \
    glds16(a_ + (size_t)96 * lda, la_ + 12288);                                              \
    glds16(b_, la_ + 32768);                                                                 \
    glds16(b_ + (size_t)32 * ldb, la_ + 32768 + 4096);                                       \
    glds16(b_ + (size_t)64 * ldb, la_ + 32768 + 8192);                                       \
    glds16(b_ + (size_t)96 * ldb, la_ + 32768 + 12288);                                      \
  }
#define D_STEP(BUF, IDX, NBUF)                                                               \
  {                                                                                          \
    const char* sa = sm + (BUF) * 16384;                                                     \
    const char* sb = sm + 32768 + (BUF) * 16384;                                             \
    bf16x8 af[2][4], bfr[2][4];                                                              \
    _Pragma("unroll") for (int kk = 0; kk < 2; ++kk) {                                       \
      _Pragma("unroll") for (int m = 0; m < 4; ++m) af[kk][m] = *reinterpret_cast<const bf16x8*>(sa + aoff[m][kk]);  \
      _Pragma("unroll") for (int n = 0; n < 4; ++n) bfr[kk][n] = *reinterpret_cast<const bf16x8*>(sb + boff[n][kk]); \
    }                                                                                        \
    __builtin_amdgcn_sched_barrier(0);                                                       \
    D_LOAD(IDX, NBUF)                                                                        \
    __builtin_amdgcn_sched_barrier(0);                                                       \
    _Pragma("unroll") for (int kk = 0; kk < 2; ++kk)                                         \
      _Pragma("unroll") for (int m = 0; m < 4; ++m)                                          \
        _Pragma("unroll") for (int n = 0; n < 4; ++n)                                        \
          acc[m][n] = __builtin_amdgcn_mfma_f32_16x16x32_bf16(bfr[kk][n], af[kk][m], acc[m][n], 0, 0, 0);           \
    __builtin_amdgcn_sched_barrier(0);    \
  }
  if (first) {
    D_LOAD(0, 0)
    __syncthreads();
  }
  for (int kt = 0; kt < nk; kt += 2) {
    D_STEP(0, kt + 1, 1)
    __syncthreads();
    D_STEP(1, kt + 2, 0)
    __syncthreads();
  }
}

DI void acc_zero(f32x4 (&acc)[4][4]) {
#pragma unroll
  for (int m = 0; m < 4; ++m)
#pragma unroll
    for (int n = 0; n < 4; ++n) acc[m][n] = f32x4{0.f, 0.f, 0.f, 0.f};
}

#define EPI_LOOP(BODY)                                                                   \
  {                                                                                      \
    const int lane_ = tid & 63, wave_ = __builtin_amdgcn_readfirstlane(tid >> 6), wm_ = wave_ >> 1, wn_ = wave_ & 1;     \
    _Pragma("unroll") for (int m = 0; m < 4; ++m) {                                      \
      const int row = wm_ * 64 + m * 16 + (lane_ & 15);                                  \
      _Pragma("unroll") for (int n = 0; n < 4; ++n) {                                    \
        const int col = wn_ * 64 + n * 16 + (lane_ >> 4) * 4;                            \
        f32x4& v = acc[m][n];                                                            \
        BODY                                                                             \
      }                                                                                  \
    }                                                                                    \
  }

DI void store_bf4(u16* p, float a, float b, float c, float d) {
  uint2 u;
  u.x = pk2(a, b);
  u.y = pk2(c, d);
  *reinterpret_cast<uint2*>(p) = u;
}

#define XCD_TILE_LOOP(MT, NT8)                                                                        \
  const int xcd_ = blockIdx.x & 7, slot_ = blockIdx.x >> 3, nslots_ = gridDim.x >> 3;                 \
  const int mlo_ = (xcd_ * 132) >> 3, mhi_ = ((xcd_ + 1) * 132) >> 3;                                 \
  for (int it_ = slot_, MT = mlo_ + (slot_ >> 3), NT8 = slot_ & 7; it_ < (mhi_ - mlo_) * 8;           \
       it_ += nslots_, MT = mlo_ + (it_ >> 3), NT8 = it_ & 7)

#define XCD_TILE_LOOP_N(MT, NT8, MTN, NTN)                                                            \
  const int xcd_ = blockIdx.x & 7, slot_ = blockIdx.x >> 3, nslots_ = gridDim.x >> 3;                 \
  const int mlo_ = (xcd_ * 132) >> 3, mhi_ = ((xcd_ + 1) * 132) >> 3, lim_ = (mhi_ - mlo_) * 8;        \
  for (int it_ = slot_, itn_ = (slot_ + nslots_ < lim_ ? slot_ + nslots_ : slot_), MT = mlo_ + (it_ >> 3), NT8 = it_ & 7, \
           MTN = mlo_ + (itn_ >> 3), NTN = itn_ & 7;                                                  \
       it_ < lim_;                                                                                    \
       it_ += nslots_, itn_ = (it_ + nslots_ < lim_ ? it_ + nslots_ : it_), MT = mlo_ + (it_ >> 3), NT8 = it_ & 7, \
           MTN = mlo_ + (itn_ >> 3), NTN = itn_ & 7)

DI void convT_tile(const float* __restrict__ src, int ldsrc, int k0, int srccol0, u16* __restrict__ dst, int K,
                   int dstn0, const float* __restrict__ scale, float* sm, int tid) {
  float vv[16];
#pragma unroll
  for (int i = 0; i < 16; ++i) {
    const int k = i * 4 + (tid >> 6);
    float v = src[(size_t)(k0 + k) * ldsrc + srccol0 + (tid & 63)];
    if (scale) v *= scale[k0 + k];
    vv[i] = v;
  }
#pragma unroll
  for (int i = 0; i < 16; ++i) sm[(i * 4 + (tid >> 6)) * 65 + (tid & 63)] = vv[i];
  __syncthreads();
#pragma unroll
  for (int ps = 0; ps < 2; ++ps) {
    const int n = ps * 32 + (tid >> 3), kc = tid & 7;
    const float* c = sm + (kc * 8) * 65 + n;
    uint4 u;
    u.x = pk2(c[0], c[65]); u.y = pk2(c[2 * 65], c[3 * 65]); u.z = pk2(c[4 * 65], c[5 * 65]); u.w = pk2(c[6 * 65], c[7 * 65]);
    *reinterpret_cast<uint4*>(dst + (size_t)(dstn0 + n) * K + k0 + kc * 8) = u;
  }
  __syncthreads();
}

__device__ void phase_convert_weights(const Params& p, char* smem, int tid) {
  float* sm = reinterpret_cast<float*>(smem);
  for (int it = blockIdx.x; it < 6400; it += gridDim.x) {
    if (it < 4096) {
      int l = it >> 11, r = it & 2047, kt = r >> 7, nt = r & 127;
      int n0 = nt * 64;
      int srccol = n0 < 4096 ? n0 : n0 + 16;
      convT_tile(p.w_in + (size_t)l * 1024 * INW, INW, kt * 64, srccol,
                 reinterpret_cast<u16*>(p.ws + OFF_WIN) + (size_t)l * 8192 * 1024, 1024, n0, p.norm_mix + l * 1024, sm,
                 tid);
    } else if (it < 6144) {
      int r = it - 4096, which = r >> 9, l = (r >> 8) & 1, tt = r & 255, kt = tt >> 4, nt = tt & 15;
      const float* src = which == 0 ? p.w_proj_a : which == 1 ? p.w_proj_b : which == 2 ? p.w_out : p.w_ple_gate;
      size_t off = which == 0 ? OFF_WA : which == 1 ? OFF_WB : which == 2 ? OFF_WO : OFF_WG;
      convT_tile(src + (size_t)l * 1024 * 1024, 1024, kt * 64, nt * 64,
                 reinterpret_cast<u16*>(p.ws + off) + (size_t)l * 1024 * 1024, 1024, nt * 64,
                 which == 3 ? p.norm_ple + l * 1024 : nullptr, sm, tid);
    } else if (it < 6272) {
      int r = it - 6144, l = r >> 6, tt = r & 63, kt = tt >> 4, nt = tt & 15;
      convT_tile(p.w_ple_proj + (size_t)l * 256 * 1024, 1024, kt * 64, nt * 64,
                 reinterpret_cast<u16*>(p.ws + OFF_WP) + (size_t)l * 1024 * 256, 256, nt * 64, nullptr, sm, tid);
    } else {
      int r = it - 6272, lg = r >> 4, tt = r & 15, kt = tt >> 2, nt = tt & 3;
      convT_tile(p.pool_w + (size_t)lg * 256 * 256, 256, kt * 64, nt * 64,
                 reinterpret_cast<u16*>(p.ws + OFF_WPL) + (size_t)lg * 256 * 256, 256, nt * 64, nullptr, sm, tid);
    }
  }
}

__device__ void phase_prep(const Params& p, int l, char* smem, int tid) {
  float* sW = reinterpret_cast<float*>(smem);
  const float* win = p.w_in + (size_t)l * 1024 * INW;
  const float* nm = p.norm_mix + l * 1024;
  for (int i = 0; i < 64; ++i) {
    int idx = tid + 256 * i;
    int k = idx >> 4, j = idx & 15;
    sW[j * 1024 + k] = win[(size_t)k * INW + 4096 + j] * nm[k];
  }
  __syncthreads();
  const int lane = tid & 63, wave = __builtin_amdgcn_readfirstlane(tid >> 6);
  u16* hb = reinterpret_cast<u16*>(p.ws + OFF_H);
  u16* pb = reinterpret_cast<u16*>(p.ws + OFF_PB);
  float* gbuf = reinterpret_cast<float*>(p.ws + OFF_G);
  float* bbuf = reinterpret_cast<float*>(p.ws + OFF_BETA);
  auto rowptr = [&](int r) -> const float* {
    if (l == 0) return r < TP ? p.x_prompt + (size_t)r * 1024 : p.x_sample + (size_t)(r - TP) * 1024;
    return p.out + (size_t)r * 1024;
  };
  int r = blockIdx.x * 4 + wave;
  float4 xn0 = {0.f, 0.f, 0.f, 0.f}, xn1 = xn0, xn2 = xn0, xn3 = xn0;
  if (r < T) {
    const float* xr = rowptr(r);
    xn0 = *reinterpret_cast<const float4*>(xr + lane * 4);
    xn1 = *reinterpret_cast<const float4*>(xr + 256 + lane * 4);
    xn2 = *reinterpret_cast<const float4*>(xr + 512 + lane * 4);
    xn3 = *reinterpret_cast<const float4*>(xr + 768 + lane * 4);
  }
  for (; r < T; r += gridDim.x * 4) {
    float4 xv[4] = {xn0, xn1, xn2, xn3};
    const float* prow = r < TP ? p.p_prompt + ((size_t)l * TP + r) * 256 : p.p_sample + ((size_t)l * TS + (r - TP)) * 256;
    const float4 pv = *reinterpret_cast<const float4*>(prow + lane * 4);
    const int rn = r + gridDim.x * 4;
    if (rn < T) {
      const float* xr = rowptr(rn);
      xn0 = *reinterpret_cast<const float4*>(xr + lane * 4);
      xn1 = *reinterpret_cast<const float4*>(xr + 256 + lane * 4);
      xn2 = *reinterpret_cast<const float4*>(xr + 512 + lane * 4);
      xn3 = *reinterpret_cast<const float4*>(xr + 768 + lane * 4);
    }
    float ss = 0.f;
#pragma unroll
    for (int i = 0; i < 4; ++i) ss += xv[i].x * xv[i].x + xv[i].y * xv[i].y + xv[i].z * xv[i].z + xv[i].w * xv[i].w;
    float d[16];
#pragma unroll
    for (int j = 0; j < 16; ++j) d[j] = 0.f;
#pragma unroll
    for (int i = 0; i < 4; ++i) {
#pragma unroll
      for (int j = 0; j < 16; ++j) {
        float4 w = *reinterpret_cast<const float4*>(sW + j * 1024 + i * 256 + lane * 4);
        d[j] += xv[i].x * w.x + xv[i].y * w.y + xv[i].z * w.z + xv[i].w * w.w;
      }
      __builtin_amdgcn_sched_barrier(0);
    }
    ss = wave_sum(ss);
    float k8[8], k4[4], k2[2], k1;
#pragma unroll
    for (int i = 0; i < 8; ++i) {
      const float send = (lane & 32) ? d[i] : d[i + 8], keep = (lane & 32) ? d[i + 8] : d[i];
      k8[i] = keep + __shfl_xor(send, 32);
    }
#pragma unroll
    for (int i = 0; i < 4; ++i) {
      const float send = (lane & 16) ? k8[i] : k8[i + 4], keep = (lane & 16) ? k8[i + 4] : k8[i];
      k4[i] = keep + __shfl_xor(send, 16);
    }
#pragma unroll
    for (int i = 0; i < 2; ++i) {
      const float send = (lane & 8) ? k4[i] : k4[i + 2], keep = (lane & 8) ? k4[i + 2] : k4[i];
      k2[i] = keep + __shfl_xor(send, 8);
    }
    {
      const float send = (lane & 4) ? k2[0] : k2[1], keep = (lane & 4) ? k2[1] : k2[0];
      k1 = keep + __shfl_xor(send, 4);
    }
    k1 += __shfl_xor(k1, 2);
    k1 += __shfl_xor(k1, 1);
    const float rstd = rsqrtf(ss * (1.f / 1024.f) + EPS);
#pragma unroll
    for (int i = 0; i < 4; ++i)
      store_bf4(hb + (size_t)r * 1024 + i * 256 + lane * 4, xv[i].x * rstd, xv[i].y * rstd, xv[i].z * rstd, xv[i].w * rstd);
    if ((lane & 3) == 0) {
      const int j = ((lane >> 5) & 1) * 8 + ((lane >> 4) & 1) * 4 + ((lane >> 3) & 1) * 2 + ((lane >> 2) & 1);
      const float val = k1 * rstd;
      if (j < 8) {
        float xx = val + p.dt_bias[l * 8 + j];
        float sp = xx > 20.f ? xx : log1pf(__expf(xx));
        gbuf[(size_t)r * 8 + j] = -__expf(p.a_log[l * 8 + j]) * sp;
      } else {
        bbuf[(size_t)r * 8 + (j - 8)] = sigmoidf_(val);
      }
    }
    store_bf4(pb + (size_t)r * 256 + lane * 4, pv.x, pv.y, pv.z, pv.w);
  }
}

__device__ void phase_final(const Params& p, int tid) {
  const int lane = tid & 63, wave = __builtin_amdgcn_readfirstlane(tid >> 6);
  for (int r = blockIdx.x * 4 + wave; r < T; r += gridDim.x * 4) {
    float* xrow = p.out + (size_t)r * 1024;
    float4 xv[4];
    float ss = 0.f;
#pragma unroll
    for (int i = 0; i < 4; ++i) {
      xv[i] = *reinterpret_cast<const float4*>(xrow + i * 256 + lane * 4);
      ss += xv[i].x * xv[i].x + xv[i].y * xv[i].y + xv[i].z * xv[i].z + xv[i].w * xv[i].w;
    }
    ss = wave_sum(ss);
    const float rstd = rsqrtf(ss * (1.f / 1024.f) + EPS);
#pragma unroll
    for (int i = 0; i < 4; ++i) {
      float4 w = *reinterpret_cast<const float4*>(p.final_norm + i * 256 + lane * 4);
      float4 o;
      o.x = xv[i].x * rstd * w.x; o.y = xv[i].y * rstd * w.y; o.z = xv[i].z * rstd * w.z; o.w = xv[i].w * rstd * w.w;
      *reinterpret_cast<float4*>(xrow + i * 256 + lane * 4) = o;
    }
  }
}

__device__ void phase_inproj(const Params& p, int l, char* smem, int tid) {
  const u16* hb = reinterpret_cast<const u16*>(p.ws + OFF_H);
  const u16* W = reinterpret_cast<const u16*>(p.ws + OFF_WIN) + (size_t)l * 8192 * 1024;
  u16* P1 = reinterpret_cast<u16*>(p.ws + OFF_P1);
  const int xcd = blockIdx.x & 7, slot = blockIdx.x >> 3, nslots = gridDim.x >> 3;
  GREGS_DECL;
  bool first = true;
  for (int it = slot; it < 132 * 8; it += nslots) {
    const int mt = it >> 3, nt = xcd * 8 + (it & 7);
    const int itn = (it + nslots < 132 * 8) ? it + nslots : it;
    const int mtn = itn >> 3, ntn = xcd * 8 + (itn & 7);
    f32x4 acc[4][4];
    acc_zero(acc);
    gemm_dma(hb + (size_t)mt * 128 * 1024, W + (size_t)nt * 128 * 1024, hb + (size_t)mtn * 128 * 1024,
                W + (size_t)ntn * 128 * 1024, 1024, 1024, 1024, first, acc, smem, tid);
    first = false;
    u16* dst;
    size_t ld;
    if (nt < 24) { dst = P1 + (size_t)mt * 128 * 3072 + nt * 128; ld = 3072; }
    else {
      const int arr = (nt - 24) >> 3;
      const size_t off = arr == 0 ? OFF_Z : arr == 1 ? OFF_U : arr == 2 ? OFF_GP : arr == 3 ? OFF_GA : OFF_GB;
      dst = reinterpret_cast<u16*>(p.ws + off) + (size_t)mt * 128 * 1024 + ((nt - 24) & 7) * 128; ld = 1024;
    }
    EPI_LOOP({ store_bf4(dst + (size_t)row * ld + col, v[0], v[1], v[2], v[3]); })
  }
}

__device__ void phase_conv_pool(const Params& p, int l, char* smem, int tid, int mode = 3) {
  const int lane = tid & 63, wave = __builtin_amdgcn_readfirstlane(tid >> 6);
  const u16* P1 = reinterpret_cast<const u16*>(p.ws + OFF_P1);
  const u16* Ub = reinterpret_cast<const u16*>(p.ws + OFF_U);
  u16* ypre = reinterpret_cast<u16*>(p.ws + OFF_Y);
  const int n_prompt = 256 * 24;
  const int n_conv = n_prompt + 128 * 24;
  if (mode & 1)
  for (int wt = blockIdx.x * 4 + wave; wt < n_conv; wt += gridDim.x * 4) {
    const bool smp = wt >= n_prompt;
    int run, j;
    if (!smp) { run = wt / 24; j = wt % 24; } else { run = (wt - n_prompt) / 24; j = (wt - n_prompt) % 24; }
    const int col = j * 128 + lane * 2;
    const int hh = j & 7, ten = j >> 3;
    const float* cw = p.conv_w + (size_t)l * 4 * 3072 + col;
    const float2 w0 = *reinterpret_cast<const float2*>(cw);
    const float2 w1 = *reinterpret_cast<const float2*>(cw + 3072);
    const float2 w2 = *reinterpret_cast<const float2*>(cw + 2 * 3072);
    const float2 w3 = *reinterpret_cast<const float2*>(cw + 3 * 3072);
    u16* tokmaj = reinterpret_cast<u16*>(p.ws + (ten == 0 ? OFF_QA : ten == 1 ? OFF_KA : OFF_VA));
    float2 x0 = {0.f, 0.f}, x1 = {0.f, 0.f}, x2 = {0.f, 0.f};
    if (!smp) {
      const int b = run >> 5, t0 = (run & 31) * 64;
      const int ts = lane >> 4, c8 = lane & 15;
      const int seg0 = t0 + ts * 16;
      const size_t rowb = (size_t)b * 2048 + seg0;
      const int col8 = j * 128 + c8 * 8;
      char* stg = smem + wave * 16384;
      float wc[4][8];
#pragma unroll
      for (int r = 0; r < 4; ++r) {
        const float4 wa = *reinterpret_cast<const float4*>(p.conv_w + (size_t)l * 4 * 3072 + r * 3072 + col8);
        const float4 wb = *reinterpret_cast<const float4*>(p.conv_w + (size_t)l * 4 * 3072 + r * 3072 + col8 + 4);
        wc[r][0] = wa.x; wc[r][1] = wa.y; wc[r][2] = wa.z; wc[r][3] = wa.w;
        wc[r][4] = wb.x; wc[r][5] = wb.y; wc[r][6] = wb.z; wc[r][7] = wb.w;
      }
      const u16* src = P1 + rowb * 3072 + col8;
      float xw[3][8];
      {
        uint4 h0 = {0u, 0u, 0u, 0u}, h1 = h0, h2 = h0;
        if (seg0 > 0) {
          h0 = *reinterpret_cast<const uint4*>(src - (size_t)3 * 3072);
          h1 = *reinterpret_cast<const uint4*>(src - (size_t)2 * 3072);
          h2 = *reinterpret_cast<const uint4*>(src - (size_t)1 * 3072);
        }
#define UNPK8(DST, U) { DST[0] = bflo(U.x); DST[1] = bfhi(U.x); DST[2] = bflo(U.y); DST[3] = bfhi(U.y); \
                        DST[4] = bflo(U.z); DST[5] = bfhi(U.z); DST[6] = bflo(U.w); DST[7] = bfhi(U.w); }
        UNPK8(xw[0], h0) UNPK8(xw[1], h1) UNPK8(xw[2], h2)
      }
      uint4 rall[16];
#pragma unroll
      for (int i = 0; i < 16; ++i) rall[i] = *reinterpret_cast<const uint4*>(src + (size_t)i * 3072);
#pragma unroll
      for (int qb = 0; qb < 4; ++qb) {
        uint4 rows[4];
#pragma unroll
        for (int i = 0; i < 4; ++i) rows[i] = rall[qb * 4 + i];
        float o[4][8];
        float ss[4];
#pragma unroll
        for (int i = 0; i < 4; ++i) {
          float x3[8];
          UNPK8(x3, rows[i])
          float sacc = 0.f;
#pragma unroll
          for (int c = 0; c < 8; ++c) {
            float v = xw[0][c] * wc[0][c] + xw[1][c] * wc[1][c] + xw[2][c] * wc[2][c] + x3[c] * wc[3][c];
            v = siluf_(v);
            o[i][c] = v;
            sacc += v * v;
            xw[0][c] = xw[1][c]; xw[1][c] = xw[2][c]; xw[2][c] = x3[c];
          }
          ss[i] = sacc;
          const int tseq = seg0 + qb * 4 + i;
          if (tseq >= 2045) {
            float* po = p.out + O_CONVP + ((size_t)(l * 8 + b) * 3 + (tseq - 2045)) * 3072 + col8;
            *reinterpret_cast<float4*>(po) = float4{x3[0], x3[1], x3[2], x3[3]};
            *reinterpret_cast<float4*>(po + 4) = float4{x3[4], x3[5], x3[6], x3[7]};
          }
        }
        if (ten < 2) {
#pragma unroll
          for (int ofs = 8; ofs >= 1; ofs >>= 1) {
#pragma unroll
            for (int i = 0; i < 4; ++i) ss[i] += __shfl_xor(ss[i], ofs);
          }
#pragma unroll
          for (int i = 0; i < 4; ++i) {
            float sc = rsqrtf(ss[i] + EPS);
            if (ten == 0) sc *= 0.08838834764831845f;
#pragma unroll
            for (int c = 0; c < 8; ++c) o[i][c] *= sc;
            uint4 w;
            w.x = pk2(o[i][0], o[i][1]); w.y = pk2(o[i][2], o[i][3]); w.z = pk2(o[i][4], o[i][5]); w.w = pk2(o[i][6], o[i][7]);
            *reinterpret_cast<uint4*>(tokmaj + (rowb + qb * 4 + i) * 1024 + hh * 128 + c8 * 8) = w;
          }
        }
        if (ten >= 1) {
          const int chunk8 = ts * 4 + qb;
#pragma unroll
          for (int c = 0; c < 8; ++c) {
            const int ch = c8 * 8 + c;
            uint2 w;
            w.x = pk2(o[0][c], o[1][c]); w.y = pk2(o[2][c], o[3][c]);
            *reinterpret_cast<uint2*>(stg + ch * 128 + (((chunk8 >> 1) ^ (c8 & 7)) * 16) + (chunk8 & 1) * 8) = w;
          }
        }
        __builtin_amdgcn_sched_barrier(0);
      }
      if (ten >= 1) {
        asm volatile("s_waitcnt lgkmcnt(0)" ::: "memory");
        u16* tr = reinterpret_cast<u16*>(p.ws + (ten == 1 ? OFF_KT : OFF_VA)) + ((size_t)(b * 8 + hh) * 128) * 2048 + t0;
#pragma unroll 4
        for (int k = 0; k < 16; ++k) {
          const int pc = lane + 64 * k, ch = pc >> 3, c = pc & 7;
          const uint4 v = *reinterpret_cast<const uint4*>(stg + ch * 128 + ((c ^ ((ch >> 3) & 7)) * 16));
          *reinterpret_cast<uint4*>(tr + (unsigned)(ch * 2048 + c * 8)) = v;
        }
        asm volatile("s_waitcnt lgkmcnt(0)" ::: "memory");
      }
    } else {
      const int b = run, base = TP + b * 4;
      const float* sc0 = p.state_conv + ((size_t)(l * 128 + b) * 3) * 3072 + col;
      x0 = *reinterpret_cast<const float2*>(sc0);
      x1 = *reinterpret_cast<const float2*>(sc0 + 3072);
      x2 = *reinterpret_cast<const float2*>(sc0 + 2 * 3072);
      unsigned ur[4];
#pragma unroll
      for (int i = 0; i < 4; ++i) ur[i] = *reinterpret_cast<const unsigned*>(P1 + (size_t)(base + i) * 3072 + col);
#pragma unroll
      for (int i = 0; i < 4; ++i) {
        unsigned u3 = ur[i];
        float2 x3 = {bflo(u3), bfhi(u3)};
        float oa = x0.x * w0.x + x1.x * w1.x + x2.x * w2.x + x3.x * w3.x;
        float ob = x0.y * w0.y + x1.y * w1.y + x2.y * w2.y + x3.y * w3.y;
        oa = siluf_(oa); ob = siluf_(ob);
        if (ten < 2) {
          float ss = wave_sum(oa * oa + ob * ob);
          float sc = rsqrtf(ss + EPS);
          if (ten == 0) sc *= 0.08838834764831845f;
          oa *= sc; ob *= sc;
        }
        *reinterpret_cast<unsigned*>(tokmaj + (size_t)(base + i) * 1024 + hh * 128 + lane * 2) = pk2(oa, ob);
        if (i >= 1)
          *reinterpret_cast<float2*>(p.out + O_CONVS + ((size_t)(l * 128 + b) * 3 + (i - 1)) * 3072 + col) = x3;
        x0 = x1; x1 = x2; x2 = x3;
      }
    }
  }
  const int col = tid * 4;
  const int win = 2 << wave;
  if (mode & 2)
  for (int bt = blockIdx.x; bt < 64 + 512; bt += gridDim.x) {
    if (bt < 64) {
      for (int i = 0; i < 8; ++i) {
        const int tt = TP + bt * 8 + i;
        const int sb = (tt - TP) >> 2, t = (tt - TP) & 3;
        const float* sp = p.state_pool + ((size_t)(l * 128 + sb) * 15) * 1024 + col;
        float s0 = 0.f, s1 = 0.f, s2 = 0.f, s3 = 0.f;
        float4 ut = {0.f, 0.f, 0.f, 0.f};
#pragma unroll
        for (int k = 0; k < 16; ++k) {
          if (k < win) {
            const int ti = t - k;
            float a0, a1, a2, a3;
            if (ti >= 0) {
              uint2 u = *reinterpret_cast<const uint2*>(Ub + (size_t)(tt - k) * 1024 + col);
              a0 = bflo(u.x); a1 = bfhi(u.x); a2 = bflo(u.y); a3 = bfhi(u.y);
            } else {
              float4 hh = *reinterpret_cast<const float4*>(sp + (size_t)(15 + ti) * 1024);
              a0 = hh.x; a1 = hh.y; a2 = hh.z; a3 = hh.w;
            }
            if (k == 0) ut = {a0, a1, a2, a3};
            s0 += a0; s1 += a1; s2 += a2; s3 += a3;
          }
        }
        float* po = p.out + O_POOLS + ((size_t)(l * 128 + sb) * 15) * 1024 + col;
        *reinterpret_cast<float4*>(po + (size_t)(11 + t) * 1024) = ut;
        if (t == 0) {
#pragma unroll
          for (int r = 0; r < 11; ++r)
            *reinterpret_cast<float4*>(po + (size_t)r * 1024) = *reinterpret_cast<const float4*>(sp + (size_t)(r + 4) * 1024);
        }
        const float inv = 1.f / (float)win;
        store_bf4(ypre + (size_t)tt * 1024 + col, s0 * inv - ut.x, s1 * inv - ut.y, s2 * inv - ut.z, s3 * inv - ut.w);
      }
    } else {
      const int tb = (bt - 64) * 32;
      const int b = tb >> 11, t0 = tb & 2047;
      float s0 = 0.f, s1 = 0.f, s2 = 0.f, s3 = 0.f;
#pragma unroll
      for (int k = 1; k < 16; ++k) {
        if (k < win && t0 - k >= 0) {
          uint2 u = *reinterpret_cast<const uint2*>(Ub + (size_t)(tb - k) * 1024 + col);
          s0 += bflo(u.x); s1 += bfhi(u.x); s2 += bflo(u.y); s3 += bfhi(u.y);
        }
      }
      for (int c8 = 0; c8 < 32; c8 += 8) {
        uint2 un[8], uo[8];
#pragma unroll
        for (int i = 0; i < 8; ++i) {
          un[i] = *reinterpret_cast<const uint2*>(Ub + (size_t)(tb + c8 + i) * 1024 + col);
          const int told = t0 + c8 + i - win + 1;
          uo[i] = told >= 0 ? *reinterpret_cast<const uint2*>(Ub + (size_t)(tb + c8 + i - win + 1) * 1024 + col) : uint2{0u, 0u};
        }
#pragma unroll
        for (int i = 0; i < 8; ++i) {
          const int t = t0 + c8 + i;
          const float a0 = bflo(un[i].x), a1 = bfhi(un[i].x), a2 = bflo(un[i].y), a3 = bfhi(un[i].y);
          s0 += a0; s1 += a1; s2 += a2; s3 += a3;
          const float inv = frcp_((float)min(t + 1, win));
          store_bf4(ypre + (size_t)(tb + c8 + i) * 1024 + col, s0 * inv - a0, s1 * inv - a1, s2 * inv - a2, s3 * inv - a3);
          if (t >= 2033)
            *reinterpret_cast<float4*>(p.out + O_POOLP + ((size_t)(l * 8 + b) * 15 + (t - 2033)) * 1024 + col) = float4{a0, a1, a2, a3};
          s0 -= bflo(uo[i].x); s1 -= bfhi(uo[i].x); s2 -= bflo(uo[i].y); s3 -= bfhi(uo[i].y);
        }
      }
    }
  }
}

__device__ void scan_task(const Params& p, int l, int seq, int h, int vgb, char* smem, int tid) {
  const int lane = tid & 63, wave = __builtin_amdgcn_readfirstlane(tid >> 6), v = lane & 15, kq = lane >> 4;
  const int vg = vgb + wave;
  const u16* Qa = reinterpret_cast<const u16*>(p.ws + OFF_QA);
  const u16* Ka = reinterpret_cast<const u16*>(p.ws + OFF_KA);
  const u16* Va = reinterpret_cast<const u16*>(p.ws + OFF_VA);
  const float* gbuf = reinterpret_cast<const float*>(p.ws + OFF_G);
  const float* bbuf = reinterpret_cast<const float*>(p.ws + OFF_BETA);
  u16* oraw = reinterpret_cast<u16*>(p.ws + OFF_ORAW);
  const int tok0 = TP + seq * 4;
  const int nT = 4;
  float S[32];
  float* sout;
  {
    const float* s0 = p.state_delta + (((size_t)(l * 128 + seq) * 8 + h) * 128 + kq * 32) * 128 + vg * 16 + v;
#pragma unroll
    for (int i = 0; i < 32; ++i) S[i] = s0[(size_t)i * 128];
    sout = p.out + O_DELTAS + (((size_t)(l * 128 + seq) * 8 + h) * 128 + kq * 32) * 128 + vg * 16 + v;
  }
  uint4 pre0, pre1, pre2, pre3, pre4;
  float pg = 0.f, pbeta = 0.f;
#define SCAN_LD1(J, VAR)                                                                                          \
  {                                                                                                               \
    const int pc = tid + 256 * (J);                                                                               \
    const int tk = pc / 40, w = pc % 40;                                                                          \
    const size_t ro = (size_t)(tok0 + c0_ + (tk < n_ ? tk : 0)) * 1024 + h * 128;                                 \
    const u16* src = w < 16 ? Ka + ro + w * 8 : w < 32 ? Qa + ro + (w - 16) * 8 : Va + ro + vgb * 16 + (w - 32) * 8; \
    VAR = *reinterpret_cast<const uint4*>(src);                                                                   \
  }
#define SCAN_PREFETCH(C0)                                                                                         \
  {                                                                                                               \
    const int c0_ = (C0);                                                                                         \
    const int n_ = min(32, nT - c0_);                                                                             \
    SCAN_LD1(0, pre0) SCAN_LD1(1, pre1) SCAN_LD1(2, pre2) SCAN_LD1(3, pre3) SCAN_LD1(4, pre4)                     \
    if (tid < 32) {                                                                                               \
      const int tk = tid < n_ ? tid : 0;                                                                          \
      pg = gbuf[(size_t)(tok0 + c0_ + tk) * 8 + h];                                                               \
      pbeta = bbuf[(size_t)(tok0 + c0_ + tk) * 8 + h];                                                            \
    }                                                                                                             \
  }
#define SCAN_ST1(J, VAR)                                                                                          \
  {                                                                                                               \
    const int pc = tid + 256 * (J);                                                                               \
    const int tk = pc / 40, w = pc % 40;                                                                          \
    if (tk < n) {                                                                                                 \
      const int dst = tk * 640 + (w < 16 ? w * 16 : w < 32 ? 256 + (w - 16) * 16 : 512 + (w - 32) * 16);          \
      *reinterpret_cast<uint4*>(smem + dst) = VAR;                                                                \
    }                                                                                                             \
  }
  SCAN_PREFETCH(0)
  for (int c0 = 0; c0 < nT; c0 += 32) {
    const int n = min(32, nT - c0);
    __syncthreads();
    SCAN_ST1(0, pre0) SCAN_ST1(1, pre1) SCAN_ST1(2, pre2) SCAN_ST1(3, pre3) SCAN_ST1(4, pre4)
    if (tid < 32) {
      *reinterpret_cast<float*>(smem + 20480 + tid * 4) = pg;
      *reinterpret_cast<float*>(smem + 20480 + 128 + tid * 4) = pbeta;
    }
    __syncthreads();
    if (c0 + 32 < nT) SCAN_PREFETCH(c0 + 32)
    for (int tt = 0; tt < n; ++tt) {
      const char* rowb = smem + tt * 640;
      uint4 kw[4], qw[4];
#pragma unroll
      for (int i = 0; i < 4; ++i) {
        kw[i] = *reinterpret_cast<const uint4*>(rowb + kq * 64 + i * 16);
        qw[i] = *reinterpret_cast<const uint4*>(rowb + 256 + kq * 64 + i * 16);
      }
      const float vv = __uint_as_float((unsigned)(*reinterpret_cast<const u16*>(rowb + 512 + (wave * 16 + v) * 2)) << 16);
      const float gv = *reinterpret_cast<const float*>(smem + 20480 + tt * 4);
      const float be = *reinterpret_cast<const float*>(smem + 20480 + 128 + tt * 4);
      const float a = __expf(gv);
      float kf[32];
#pragma unroll
      for (int i = 0; i < 4; ++i) {
        kf[i * 8 + 0] = bflo(kw[i].x); kf[i * 8 + 1] = bfhi(kw[i].x);
        kf[i * 8 + 2] = bflo(kw[i].y); kf[i * 8 + 3] = bfhi(kw[i].y);
        kf[i * 8 + 4] = bflo(kw[i].z); kf[i * 8 + 5] = bfhi(kw[i].z);
        kf[i * 8 + 6] = bflo(kw[i].w); kf[i * 8 + 7] = bfhi(kw[i].w);
      }
      float r0 = 0.f, r1 = 0.f;
#pragma unroll
      for (int i = 0; i < 32; i += 2) { r0 += kf[i] * S[i]; r1 += kf[i + 1] * S[i + 1]; }
      float r = r0 + r1;
      r += __shfl_xor(r, 16);
      r += __shfl_xor(r, 32);
      const float u = be * (vv - a * r);
#pragma unroll
      for (int i = 0; i < 32; ++i) S[i] = a * S[i] + kf[i] * u;
      float o0 = 0.f, o1 = 0.f;
#pragma unroll
      for (int i = 0; i < 4; ++i) {
        o0 += bflo(qw[i].x) * S[i * 8 + 0]; o1 += bfhi(qw[i].x) * S[i * 8 + 1];
        o0 += bflo(qw[i].y) * S[i * 8 + 2]; o1 += bfhi(qw[i].y) * S[i * 8 + 3];
        o0 += bflo(qw[i].z) * S[i * 8 + 4]; o1 += bfhi(qw[i].z) * S[i * 8 + 5];
        o0 += bflo(qw[i].w) * S[i * 8 + 6]; o1 += bfhi(qw[i].w) * S[i * 8 + 7];
      }
      float o = o0 + o1;
      o += __shfl_xor(o, 16);
      o += __shfl_xor(o, 32);
      if (kq == 0) oraw[(size_t)(tok0 + c0 + tt) * 1024 + h * 128 + vg * 16 + v] = (u16)(pk2(o, o) & 0xffffu);
    }
  }
#pragma unroll
  for (int i = 0; i < 32; ++i) sout[(size_t)i * 128] = S[i];
}

__device__ void pool_gemm_tile(const Params& p, int l, int tl, char* smem, int tid) {
  const int mt = tl >> 3, r = tl & 7, g = r >> 1, nh = r & 1;
  const u16* ypre = reinterpret_cast<const u16*>(p.ws + OFF_Y);
  const u16* W = reinterpret_cast<const u16*>(p.ws + OFF_WPL) + (size_t)(l * 4 + g) * 256 * 256;
  const u16* GP = reinterpret_cast<const u16*>(p.ws + OFF_GP);
  u16* ybin = ybin_row(p.ws, (size_t)mt * 128) - (size_t)mt * 128 * 1024;
  f32x4 acc[4][4];
  acc_zero(acc);
  gemm_dma(ypre + (size_t)mt * 128 * 1024 + g * 256, W + (size_t)nh * 128 * 256, ypre + (size_t)mt * 128 * 1024 + g * 256, W + (size_t)nh * 128 * 256, 1024, 256, 256, true, acc, smem, tid);
  const int c0 = g * 256 + nh * 128;
  const float* psc = p.pool_scale + l * 1024 + c0;
  EPI_LOOP({
    const size_t t = (size_t)mt * 128 + row;
    float4 sc = *reinterpret_cast<const float4*>(psc + col);
    uint2 gp = *reinterpret_cast<const uint2*>(GP + t * 1024 + c0 + col);
    store_bf4(ybin + t * 1024 + c0 + col, v[0] * sc.x * siluf_(bflo(gp.x)), v[1] * sc.y * siluf_(bfhi(gp.x)),
              v[2] * sc.z * siluf_(bflo(gp.y)), v[3] * sc.w * siluf_(bfhi(gp.y)));
  })
}

DI bf16x8 frag_nat(const char* base, int stride, int row0, int kb, int lane) {
  return *reinterpret_cast<const bf16x8*>(base + (row0 + (lane & 15)) * stride + (kb * 32 + (lane >> 4) * 8) * 2);
}
DI bf16x8 frag_perm(const char* base, int stride, int row0, int kb, int lane) {
  const char* pp = base + (row0 + (lane & 15)) * stride + (kb * 32 + (lane >> 4) * 4) * 2;
  uint2 a = *reinterpret_cast<const uint2*>(pp);
  uint2 b = *reinterpret_cast<const uint2*>(pp + 32);
  uint4 u = {a.x, a.y, b.x, b.y};
  return __builtin_bit_cast(bf16x8, u);
}
DI bf16x8 pack_acc(const f32x4& a, const f32x4& b) {
  uint4 u = {pk2(a[0], a[1]), pk2(a[2], a[3]), pk2(b[0], b[1]), pk2(b[2], b[3])};
  return __builtin_bit_cast(bf16x8, u);
}
#define MFMA16(X, Y, C) __builtin_amdgcn_mfma_f32_16x16x32_bf16((X), (Y), (C), 0, 0, 0)
DI uint4 scale8(uint4 u, float s0, float s1, float s2, float s3, float s4, float s5, float s6, float s7) {
  uint4 r;
  r.x = pk2(bflo(u.x) * s0, bfhi(u.x) * s1);
  r.y = pk2(bflo(u.y) * s2, bfhi(u.y) * s3);
  r.z = pk2(bflo(u.z) * s4, bfhi(u.z) * s5);
  r.w = pk2(bflo(u.w) * s6, bfhi(u.w) * s7);
  return r;
}

template <int I, int G>
DI void solve_group(float (&t)[64], float& acc, const float* __restrict__ sA) {
  if constexpr (G * 32 < I) {
    float4 cur[8];
#pragma unroll
    for (int j4 = 0; j4 < 8; ++j4)
      if ((G * 8 + j4) * 4 < I) cur[j4] = *reinterpret_cast<const float4*>(sA + I * 68 + (G * 8 + j4) * 4);
    __builtin_amdgcn_sched_barrier(0);
#pragma unroll
    for (int j4 = 0; j4 < 8; ++j4) {
      constexpr int dummy = 0; (void)dummy;
      const int jb = (G * 8 + j4) * 4;
      if (jb < I) {
        const float4 a = cur[j4];
        if (jb + 0 < I) acc -= a.x * t[jb + 0];
        if (jb + 1 < I) acc -= a.y * t[jb + 1];
        if (jb + 2 < I) acc -= a.z * t[jb + 2];
        if (jb + 3 < I) acc -= a.w * t[jb + 3];
      }
    }
    __builtin_amdgcn_sched_barrier(0);
  }
}
template <int I>
DI void solve_rows(float (&t)[64], const float* __restrict__ sA, int lane) {
  if constexpr (I < 64) {
    float acc = (lane == I) ? 1.f : 0.f;
    solve_group<I, 0>(t, acc, sA);
    solve_group<I, 1>(t, acc, sA);
    t[I] = acc;
    solve_rows<I + 1>(t, sA, lane);
  }
}

__device__ void phase_chunk_prep(const Params& p, int l, char* smem, int tid) {
  const int lane = tid & 63, wave = __builtin_amdgcn_readfirstlane(tid >> 6), r16 = lane & 15, q4 = lane >> 4;
  char* sK = smem;
  char* sQ = smem + 17408;
  char* sKT = smem;
  char* sVT = smem + 18432;
  float* sA = reinterpret_cast<float*>(smem + 36864);
  char* sT = smem + 36864 + 17408;
  float* sG = reinterpret_cast<float*>(smem + 36864 + 17408 + 9216);
  float* sB = sG + 64;
  const u16* Qa = reinterpret_cast<const u16*>(p.ws + OFF_QA);
  const u16* Ka = reinterpret_cast<const u16*>(p.ws + OFF_KA);
  const u16* KT = reinterpret_cast<const u16*>(p.ws + OFF_KT);
  const u16* VT = reinterpret_cast<const u16*>(p.ws + OFF_VA);
  const float* gbuf = reinterpret_cast<const float*>(p.ws + OFF_G);
  const float* bbuf = reinterpret_cast<const float*>(p.ws + OFF_BETA);
  float* GL = reinterpret_cast<float*>(p.ws + OFF_GL);
  for (int cid = blockIdx.x; cid < 2048; cid += gridDim.x) {
    const int bh = cid >> 5, n = cid & 31, b = bh >> 3, h = bh & 7;
    const int tok0 = b * 2048 + n * 64;
    u16* img = reinterpret_cast<u16*>(p.ws + OFF_IMG + (size_t)cid * IMG_BYTES);
    u16* wvt = reinterpret_cast<u16*>(p.ws + OFF_WVT + (size_t)cid * 16384);
    __syncthreads();
    if (tid < 64) {
      float g = gbuf[(size_t)(tok0 + tid) * 8 + h];
#pragma unroll
      for (int o = 1; o < 64; o <<= 1) {
        float t = __shfl_up(g, o);
        if (lane >= o) g += t;
      }
      sG[tid] = g;
      sB[tid] = bbuf[(size_t)(tok0 + tid) * 8 + h];
    }
#pragma unroll
    for (int j = 0; j < 4; ++j) {
      const int pc = tid + 256 * j, row = pc >> 4, c16 = pc & 15;
      *reinterpret_cast<uint4*>(sK + row * 272 + c16 * 16) =
          *reinterpret_cast<const uint4*>(Ka + (size_t)(tok0 + row) * 1024 + h * 128 + c16 * 8);
      *reinterpret_cast<uint4*>(sQ + row * 272 + c16 * 16) =
          *reinterpret_cast<const uint4*>(Qa + (size_t)(tok0 + row) * 1024 + h * 128 + c16 * 8);
    }
    __syncthreads();
    {
      bf16x8 yk[4], yq[4];
#pragma unroll
      for (int kb = 0; kb < 4; ++kb) {
        yk[kb] = frag_nat(sK, 272, wave * 16, kb, lane);
        yq[kb] = frag_nat(sQ, 272, wave * 16, kb, lane);
      }
      const int jy = wave * 16 + r16;
      const float Gy = sG[jy];
#pragma unroll
      for (int it = 0; it < 4; ++it) {
        f32x4 akk = {0.f, 0.f, 0.f, 0.f}, aqk = {0.f, 0.f, 0.f, 0.f};
#pragma unroll
        for (int kb = 0; kb < 4; ++kb) {
          bf16x8 xk = frag_nat(sK, 272, it * 16, kb, lane);
          akk = MFMA16(xk, yk[kb], akk);
          aqk = MFMA16(xk, yq[kb], aqk);
        }
        float wq[4];
#pragma unroll
        for (int e = 0; e < 4; ++e) {
          const int i = it * 16 + q4 * 4 + e;
          const float Gi = sG[i];
          sA[i * 68 + jy] = (i > jy) ? sB[i] * akk[e] * __expf(Gi - Gy) : 0.f;
          wq[e] = (jy >= i) ? aqk[e] * __expf(Gy - Gi) : 0.f;
        }
        store_bf4(img + 16384 + jy * 64 + it * 16 + q4 * 4, wq[0], wq[1], wq[2], wq[3]);
      }
    }
    __syncthreads();
    if (wave == 0) {
      float t[64];
      solve_rows<0>(t, sA, lane);
#pragma unroll
      for (int i = 0; i < 64; ++i) *reinterpret_cast<u16*>(sT + i * 144 + lane * 2) = (u16)(pk2(t[i], t[i]) & 0xffffu);
    } else {
      const float Glast = sG[63];
      if (tid == 64) GL[cid] = __expf(Glast);
#pragma unroll 1
      for (int pc = tid - 64; pc < 1024; pc += 192) {
        const int c = pc >> 3, i8 = pc & 7;
        uint4 uk = *reinterpret_cast<const uint4*>(KT + ((size_t)bh * 128 + c) * 2048 + n * 64 + i8 * 8);
        uint4 uv = *reinterpret_cast<const uint4*>(VT + ((size_t)bh * 128 + c) * 2048 + n * 64 + i8 * 8);
        const float* gp = sG + i8 * 8;
        const float* bp = sB + i8 * 8;
        *reinterpret_cast<uint4*>(sKT + c * 144 + i8 * 16) =
            scale8(uk, bp[0] * __expf(gp[0]), bp[1] * __expf(gp[1]), bp[2] * __expf(gp[2]), bp[3] * __expf(gp[3]),
                   bp[4] * __expf(gp[4]), bp[5] * __expf(gp[5]), bp[6] * __expf(gp[6]), bp[7] * __expf(gp[7]));
        *reinterpret_cast<uint4*>(sVT + c * 144 + i8 * 16) = scale8(uv, bp[0], bp[1], bp[2], bp[3], bp[4], bp[5], bp[6], bp[7]);
        *reinterpret_cast<uint4*>(img + 20480 + c * 64 + i8 * 8) =
            scale8(uk, __expf(Glast - gp[0]), __expf(Glast - gp[1]), __expf(Glast - gp[2]), __expf(Glast - gp[3]),
                   __expf(Glast - gp[4]), __expf(Glast - gp[5]), __expf(Glast - gp[6]), __expf(Glast - gp[7]));
      }
#pragma unroll 1
      for (int pc = tid - 64; pc < 1024; pc += 192) {
        const int i = pc >> 4, c16 = pc & 15;
        uint4 u = *reinterpret_cast<const uint4*>(Qa + (size_t)(tok0 + i) * 1024 + h * 128 + c16 * 8);
        const float sc = __expf(sG[i]);
        *reinterpret_cast<uint4*>(img + 8192 + i * 128 + c16 * 8) = scale8(u, sc, sc, sc, sc, sc, sc, sc, sc);
      }
    }
    __syncthreads();
    {
      bf16x8 yt[2];
#pragma unroll
      for (int kb = 0; kb < 2; ++kb) yt[kb] = frag_nat(sT, 144, wave * 16, kb, lane);
      const int iy = wave * 16 + r16;
#pragma unroll
      for (int ct = 0; ct < 8; ++ct) {
        f32x4 a = {0.f, 0.f, 0.f, 0.f};
#pragma unroll
        for (int kb = 0; kb < 2; ++kb) a = MFMA16(frag_nat(sKT, 144, ct * 16, kb, lane), yt[kb], a);
        store_bf4(img + iy * 128 + ct * 16 + q4 * 4, -a[0], -a[1], -a[2], -a[3]);
      }
#pragma unroll
      for (int v2 = 0; v2 < 2; ++v2) {
        const int vt = wave * 2 + v2;
        bf16x8 yv[2];
#pragma unroll
        for (int kb = 0; kb < 2; ++kb) yv[kb] = frag_nat(sVT, 144, vt * 16, kb, lane);
#pragma unroll
        for (int it = 0; it < 4; ++it) {
          f32x4 a = {0.f, 0.f, 0.f, 0.f};
#pragma unroll
          for (int kb = 0; kb < 2; ++kb) a = MFMA16(frag_nat(sT, 144, it * 16, kb, lane), yv[kb], a);
          store_bf4(wvt + (vt * 16 + r16) * 64 + it * 16 + q4 * 4, a[0], a[1], a[2], a[3]);
        }
      }
    }
  }
}

#define PRE_LIST(X) X(0) X(1) X(2) X(3) X(4) X(5) X(6) X(7) X(8) X(9) X(10) X(11) X(12) X(13)
__device__ void chunk_scan_task(const Params& p, int l, int bh, int vhalf, char* smem, int tid) {
  const int lane = tid & 63, wave = __builtin_amdgcn_readfirstlane(tid >> 6), r16 = lane & 15, q4 = lane >> 4;
  const int b = bh >> 3, h = bh & 7;
  const int v0 = vhalf * 64 + wave * 16;
  const char* img0 = p.ws + OFF_IMG + (size_t)(bh * 32) * IMG_BYTES;
  const u16* wvt0 = reinterpret_cast<const u16*>(p.ws + OFF_WVT + (size_t)(bh * 32) * 16384);
  const float* GL = reinterpret_cast<const float*>(p.ws + OFF_GL) + bh * 32;
  u16* oraw = reinterpret_cast<u16*>(p.ws + OFF_ORAW);
  char* sWk = smem;
  char* sQd = smem + 17408;
  char* sQK = smem + 34816;
  char* sKtT = smem + 44032;
  f32x4 S[8];
#pragma unroll
  for (int i = 0; i < 8; ++i) S[i] = f32x4{0.f, 0.f, 0.f, 0.f};
#define PRE_DECL(J) uint4 pre##J;
  PRE_LIST(PRE_DECL)
  uint2 wv0, wv1, wv2, wv3;
  float gln;
#define PRE_LOAD(J) pre##J = *reinterpret_cast<const uint4*>(imgn + J * 4096 + voff);
#define SCAN_FETCH(N)                                                                                   \
  {                                                                                                     \
    const char* imgn = img0 + (size_t)(N) * IMG_BYTES;                                                  \
    PRE_LIST(PRE_LOAD)                                                                                  \
    const u16* wp = wvt0 + (size_t)(N) * 8192 + wvoff;                                                  \
    wv0 = *reinterpret_cast<const uint2*>(wp);                                                          \
    wv1 = *reinterpret_cast<const uint2*>(wp + 16);                                                     \
    wv2 = *reinterpret_cast<const uint2*>(wp + 32);                                                     \
    wv3 = *reinterpret_cast<const uint2*>(wp + 48);                                                     \
    gln = GL[N];                                                                                        \
  }
#define PRE_STORE(J)                                                                                    \
  {                                                                                                     \
    const int pc = tid + 256 * J;                                                                       \
    int off;                                                                                            \
    if (J < 4) off = (pc >> 4) * 272 + (pc & 15) * 16;                                                  \
    else if (J < 8) off = 17408 + ((pc - 1024) >> 4) * 272 + (pc & 15) * 16;                            \
    else if (J < 10) off = 34816 + ((pc - 2048) >> 3) * 144 + (pc & 7) * 16;                            \
    else off = 44032 + ((pc - 2560) >> 3) * 144 + (pc & 7) * 16;                                        \
    *reinterpret_cast<uint4*>(smem + off) = pre##J;                                                     \
  }
  const unsigned voff = (unsigned)tid * 16u;
  const unsigned wvoff = (unsigned)((v0 + r16) * 64 + q4 * 4);
  SCAN_FETCH(0)
  for (int n = 0; n < 32; ++n) {
    __syncthreads();
    PRE_LIST(PRE_STORE)
    __syncthreads();
    const uint2 c0 = wv0, c1 = wv1, c2 = wv2, c3 = wv3;
    const float gl = gln;
    if (n + 1 < 32) SCAN_FETCH(n + 1)
    bf16x8 Sop[4];
#pragma unroll
    for (int kb = 0; kb < 4; ++kb) Sop[kb] = pack_acc(S[2 * kb], S[2 * kb + 1]);
    f32x4 U[4];
    U[0] = f32x4{bflo(c0.x), bfhi(c0.x), bflo(c0.y), bfhi(c0.y)};
    U[1] = f32x4{bflo(c1.x), bfhi(c1.x), bflo(c1.y), bfhi(c1.y)};
    U[2] = f32x4{bflo(c2.x), bfhi(c2.x), bflo(c2.y), bfhi(c2.y)};
    U[3] = f32x4{bflo(c3.x), bfhi(c3.x), bflo(c3.y), bfhi(c3.y)};
#pragma unroll
    for (int it = 0; it < 4; ++it) {
#pragma unroll
      for (int kb = 0; kb < 4; ++kb) U[it] = MFMA16(frag_perm(sWk, 272, it * 16, kb, lane), Sop[kb], U[it]);
    }
    bf16x8 Uop[2];
    Uop[0] = pack_acc(U[0], U[1]);
    Uop[1] = pack_acc(U[2], U[3]);
    const size_t tokb = (size_t)b * 2048 + n * 64;
    const unsigned olane = (unsigned)(q4 * 4 * 1024 + v0 + r16);
#pragma unroll
    for (int it = 0; it < 4; ++it) {
      f32x4 O = {0.f, 0.f, 0.f, 0.f};
#pragma unroll
      for (int kb = 0; kb < 4; ++kb) O = MFMA16(frag_perm(sQd, 272, it * 16, kb, lane), Sop[kb], O);
#pragma unroll
      for (int jb = 0; jb < 2; ++jb) O = MFMA16(frag_perm(sQK, 144, it * 16, jb, lane), Uop[jb], O);
#pragma unroll
      for (int e = 0; e < 4; ++e) {
        u16* pst = oraw + (tokb + it * 16 + e) * 1024 + h * 128;
        pst[olane] = (u16)(pk2(O[e], O[e]) & 0xffffu);
      }
    }
#pragma unroll
    for (int kt = 0; kt < 8; ++kt) {
      f32x4 a = S[kt];
      a[0] *= gl; a[1] *= gl; a[2] *= gl; a[3] *= gl;
#pragma unroll
      for (int jb = 0; jb < 2; ++jb) a = MFMA16(frag_perm(sKtT, 144, kt * 16, jb, lane), Uop[jb], a);
      S[kt] = a;
    }
  }
  float* sout = p.out + O_DELTAP + ((size_t)(l * 8 + b) * 8 + h) * 128 * 128 + v0 + r16;
#pragma unroll
  for (int kt = 0; kt < 8; ++kt)
#pragma unroll
    for (int e = 0; e < 4; ++e) sout[(size_t)(kt * 16 + q4 * 4 + e) * 128] = S[kt][e];
}

__device__ void pp_gemm_tile(const Params& p, int l, int tl, char* smem, int tid) {
  const int mt = tl >> 3, nt = tl & 7;
  const u16* pb = reinterpret_cast<const u16*>(p.ws + OFF_PB);
  const u16* Wp = reinterpret_cast<const u16*>(p.ws + OFF_WP) + (size_t)l * 1024 * 256;
  u16* pp = pp_row(p.ws, (size_t)mt * 128) - (size_t)mt * 128 * 1024;
  f32x4 acc[4][4];
  acc_zero(acc);
  gemm_dma(pb + (size_t)mt * 128 * 256, Wp + (size_t)nt * 128 * 256, pb + (size_t)mt * 128 * 256, Wp + (size_t)nt * 128 * 256, 256, 256, 256, true, acc, smem, tid);
  EPI_LOOP({
    const size_t t = (size_t)mt * 128 + row;
    store_bf4(pp + t * 1024 + nt * 128 + col, v[0], v[1], v[2], v[3]);
  })
}

__device__ void phase_scan(const Params& p, int l, char* smem, int tid, int cidx = 0) {
  unsigned* cnt = reinterpret_cast<unsigned*>(p.ws + OFF_CNT) + l + cidx;
  int* s_item = reinterpret_cast<int*>(smem + 65024);
  const int n_items = 128 + 2048 + 1056 + 1056;
  while (true) {
    __syncthreads();
    if (tid == 0) *s_item = (int)atomicAdd(cnt, 1u);
    __syncthreads();
    int it = *s_item;
    if (it >= n_items) break;
    it = __builtin_amdgcn_readfirstlane(it);
    int tq = tid;
    asm volatile("" : "+v"(tq));
    if (it < 128) {
      chunk_scan_task(p, l, it >> 1, it & 1, smem, tq);
    } else if (it < 128 + 2048) {
      const int wt = (it - 128) * 4;
      scan_task(p, l, wt >> 6, (wt >> 3) & 7, wt & 7, smem, tq);
    } else if (it < 128 + 2048 + 1056) {
      pool_gemm_tile(p, l, it - 2176, smem, tq);
    } else {
      pp_gemm_tile(p, l, it - 3232, smem, tq);
    }
  }
}

__device__ void phase_onorm(const Params& p, int l, int tid) {
  const int lane = tid & 63, wave = __builtin_amdgcn_readfirstlane(tid >> 6);
  const u16* oraw = reinterpret_cast<const u16*>(p.ws + OFF_ORAW);
  const u16* Zb = reinterpret_cast<const u16*>(p.ws + OFF_Z);
  u16* og = reinterpret_cast<u16*>(p.ws + OFF_OG);
  float gn[16];
#pragma unroll
  for (int i = 0; i < 4; ++i) {
    float4 w = *reinterpret_cast<const float4*>(p.gdn_norm + l * 128 + (lane & 7) * 16 + i * 4);
    gn[i * 4] = w.x; gn[i * 4 + 1] = w.y; gn[i * 4 + 2] = w.z; gn[i * 4 + 3] = w.w;
  }
  for (int r = blockIdx.x * 4 + wave; r < T; r += gridDim.x * 4) {
    uint4 o0 = *reinterpret_cast<const uint4*>(oraw + (size_t)r * 1024 + lane * 16);
    uint4 o1 = *reinterpret_cast<const uint4*>(oraw + (size_t)r * 1024 + lane * 16 + 8);
    uint4 z0 = *reinterpret_cast<const uint4*>(Zb + (size_t)r * 1024 + lane * 16);
    uint4 z1 = *reinterpret_cast<const uint4*>(Zb + (size_t)r * 1024 + lane * 16 + 8);
    float o[16], z[16];
    o[0] = bflo(o0.x); o[1] = bfhi(o0.x); o[2] = bflo(o0.y); o[3] = bfhi(o0.y);
    o[4] = bflo(o0.z); o[5] = bfhi(o0.z); o[6] = bflo(o0.w); o[7] = bfhi(o0.w);
    o[8] = bflo(o1.x); o[9] = bfhi(o1.x); o[10] = bflo(o1.y); o[11] = bfhi(o1.y);
    o[12] = bflo(o1.z); o[13] = bfhi(o1.z); o[14] = bflo(o1.w); o[15] = bfhi(o1.w);
    z[0] = bflo(z0.x); z[1] = bfhi(z0.x); z[2] = bflo(z0.y); z[3] = bfhi(z0.y);
    z[4] = bflo(z0.z); z[5] = bfhi(z0.z); z[6] = bflo(z0.w); z[7] = bfhi(z0.w);
    z[8] = bflo(z1.x); z[9] = bfhi(z1.x); z[10] = bflo(z1.y); z[11] = bfhi(z1.y);
    z[12] = bflo(z1.z); z[13] = bfhi(z1.z); z[14] = bflo(z1.w); z[15] = bfhi(z1.w);
    float ss = 0.f;
#pragma unroll
    for (int i = 0; i < 16; ++i) ss += o[i] * o[i];
    ss += __shfl_xor(ss, 1);
    ss += __shfl_xor(ss, 2);
    ss += __shfl_xor(ss, 4);
    const float rstd = rsqrtf(ss * (1.f / 128.f) + EPS);
    float y[16];
#pragma unroll
    for (int i = 0; i < 16; ++i) y[i] = o[i] * rstd * gn[i] * siluf_(z[i]);
    uint4 w0, w1;
    w0.x = pk2(y[0], y[1]); w0.y = pk2(y[2], y[3]); w0.z = pk2(y[4], y[5]); w0.w = pk2(y[6], y[7]);
    w1.x = pk2(y[8], y[9]); w1.y = pk2(y[10], y[11]); w1.z = pk2(y[12], y[13]); w1.w = pk2(y[14], y[15]);
    *reinterpret_cast<uint4*>(og + (size_t)r * 1024 + lane * 16) = w0;
    *reinterpret_cast<uint4*>(og + (size_t)r * 1024 + lane * 16 + 8) = w1;
  }
}

__device__ void phase_merge(const Params& p, int l, char* smem, int tid) {
  const u16* og = reinterpret_cast<const u16*>(p.ws + OFF_OG);
  const u16* Wa = reinterpret_cast<const u16*>(p.ws + OFF_WA) + (size_t)l * 1024 * 1024;
  const u16* Wb = reinterpret_cast<const u16*>(p.ws + OFF_WB) + (size_t)l * 1024 * 1024;
  const u16* GA = reinterpret_cast<const u16*>(p.ws + OFF_GA);
  const u16* GB = reinterpret_cast<const u16*>(p.ws + OFF_GB);
  u16* mbuf = reinterpret_cast<u16*>(p.ws + OFF_M);
  XCD_TILE_LOOP(mt, nt) {
    f32x4 acc[4][4];
    acc_zero(acc);
    gemm_dma(og + (size_t)mt * 128 * 1024, Wa + (size_t)nt * 128 * 1024, og + (size_t)mt * 128 * 1024, Wa + (size_t)nt * 128 * 1024, 1024, 1024, 1024, true, acc, smem, tid);
    EPI_LOOP({
      const size_t t = (size_t)mt * 128 + row;
      uint2 ga = *reinterpret_cast<const uint2*>(GA + t * 1024 + nt * 128 + col);
      uint2 gb = *reinterpret_cast<const uint2*>(GB + t * 1024 + nt * 128 + col);
      v[0] *= (1.f + __expf(-bflo(gb.x))) * frcp_(1.f + __expf(-bflo(ga.x)));
      v[1] *= (1.f + __expf(-bfhi(gb.x))) * frcp_(1.f + __expf(-bfhi(ga.x)));
      v[2] *= (1.f + __expf(-bflo(gb.y))) * frcp_(1.f + __expf(-bflo(ga.y)));
      v[3] *= (1.f + __expf(-bfhi(gb.y))) * frcp_(1.f + __expf(-bfhi(ga.y)));
    })
    gemm_dma(ybin_row(p.ws, (size_t)mt * 128), Wb + (size_t)nt * 128 * 1024, ybin_row(p.ws, (size_t)mt * 128), Wb + (size_t)nt * 128 * 1024, 1024, 1024, 1024, true, acc, smem, tid);
    EPI_LOOP({
      const size_t t = (size_t)mt * 128 + row;
      uint2 gb = *reinterpret_cast<const uint2*>(GB + t * 1024 + nt * 128 + col);
      store_bf4(mbuf + t * 1024 + nt * 128 + col, v[0] * sigmoidf_(bflo(gb.x)), v[1] * sigmoidf_(bfhi(gb.x)),
                v[2] * sigmoidf_(bflo(gb.y)), v[3] * sigmoidf_(bfhi(gb.y)));
    })
  }
}

__device__ void phase_out(const Params& p, int l, char* smem, int tid) {
  const u16* mbuf = reinterpret_cast<const u16*>(p.ws + OFF_M);
  const u16* Wo = reinterpret_cast<const u16*>(p.ws + OFF_WO) + (size_t)l * 1024 * 1024;
  u16* x1b = reinterpret_cast<u16*>(p.ws + OFF_Y);
  float* ssq = reinterpret_cast<float*>(p.ws + OFF_SSQ);
  GREGS_DECL;
  bool first = true;
  XCD_TILE_LOOP_N(mt, nt, mtn, ntn) {
    f32x4 acc[4][4];
    acc_zero(acc);
    {
      gemm_dma(mbuf + (size_t)mt * 128 * 1024, Wo + (size_t)nt * 128 * 1024, mbuf + (size_t)mtn * 128 * 1024,
                  Wo + (size_t)ntn * 128 * 1024, 1024, 1024, 1024, first, acc, smem, tid);
      first = false;
      const int lane_ = tid & 63, wave_ = __builtin_amdgcn_readfirstlane(tid >> 6), wm_ = wave_ >> 1, wn_ = wave_ & 1;
#pragma unroll
      for (int m = 0; m < 4; ++m) {
        const int row = wm_ * 64 + m * 16 + (lane_ & 15);
        const size_t t = (size_t)mt * 128 + row;
        const float* xin = (l == 0) ? (t < TP ? p.x_prompt + t * 1024 : p.x_sample + (t - TP) * 1024) : p.out + t * 1024;
        float ss = 0.f;
#pragma unroll
        for (int n = 0; n < 4; ++n) {
          const int col = nt * 128 + wn_ * 64 + n * 16 + (lane_ >> 4) * 4;
          float4 xi = *reinterpret_cast<const float4*>(xin + col);
          float4 o;
          o.x = xi.x + acc[m][n][0]; o.y = xi.y + acc[m][n][1]; o.z = xi.z + acc[m][n][2]; o.w = xi.w + acc[m][n][3];
          *reinterpret_cast<float4*>(p.out + t * 1024 + col) = o;
          store_bf4(x1b + t * 1024 + col, o.x, o.y, o.z, o.w);
          ss += o.x * o.x + o.y * o.y + o.z * o.z + o.w * o.w;
        }
        ss += __shfl_xor(ss, 16);
        ss += __shfl_xor(ss, 32);
        if ((lane_ >> 4) == 0) ssq[t * 16 + nt * 2 + wn_] = ss;
      }
    }
  }
}

__device__ void phase_gate(const Params& p, int l, char* smem, int tid) {
  const u16* x1b = reinterpret_cast<const u16*>(p.ws + OFF_Y);
  const u16* Wg = reinterpret_cast<const u16*>(p.ws + OFF_WG) + (size_t)l * 1024 * 1024;
  const float* ssq = reinterpret_cast<const float*>(p.ws + OFF_SSQ);
  GREGS_DECL;
  bool first = true;
  XCD_TILE_LOOP_N(mt, nt, mtn, ntn) {
    f32x4 acc[4][4];
    acc_zero(acc);
    gemm_dma(x1b + (size_t)mt * 128 * 1024, Wg + (size_t)nt * 128 * 1024, x1b + (size_t)mtn * 128 * 1024,
                Wg + (size_t)ntn * 128 * 1024, 1024, 1024, 1024, first, acc, smem, tid);
    first = false;
    const int lane_ = tid & 63, wave_ = __builtin_amdgcn_readfirstlane(tid >> 6), wm_ = wave_ >> 1, wn_ = wave_ & 1;
#pragma unroll
    for (int m = 0; m < 4; ++m) {
      const int row = wm_ * 64 + m * 16 + (lane_ & 15);
      const size_t t = (size_t)mt * 128 + row;
      float ss = 0.f;
#pragma unroll
      for (int i = 0; i < 4; ++i) {
        float4 s4 = *reinterpret_cast<const float4*>(ssq + t * 16 + i * 4);
        ss += s4.x + s4.y + s4.z + s4.w;
      }
      const float rstd = rsqrtf(ss * (1.f / 1024.f) + EPS);
#pragma unroll
      for (int n = 0; n < 4; ++n) {
        const int col = nt * 128 + wn_ * 64 + n * 16 + (lane_ >> 4) * 4;
        float4 xi = *reinterpret_cast<const float4*>(p.out + t * 1024 + col);
        uint2 pv = *reinterpret_cast<const uint2*>(pp_row(p.ws, t) + col);
        float4 o;
        o.x = xi.x + sigmoidf_(rstd * acc[m][n][0]) * bflo(pv.x);
        o.y = xi.y + sigmoidf_(rstd * acc[m][n][1]) * bfhi(pv.x);
        o.z = xi.z + sigmoidf_(rstd * acc[m][n][2]) * bflo(pv.y);
        o.w = xi.w + sigmoidf_(rstd * acc[m][n][3]) * bfhi(pv.y);
        *reinterpret_cast<float4*>(p.out + t * 1024 + col) = o;
      }
    }
  }
}

__global__ void __launch_bounds__(NT, 2) fwd_megakernel(Params p) {
  __shared__ __attribute__((aligned(16))) char smem[65536];
  cg::grid_group grid = cg::this_grid();
  __shared__ uint4 xb_words;
  if (threadIdx.x == 0) xb_words = make_uint4(0u, 0u, 0u, 0u);
  __syncthreads();
  XcdBarrier xb = xcd_barrier_post(reinterpret_cast<unsigned*>(p.ws + OFF_BAR), (volatile LAS unsigned*)&xb_words);
  if (p.ph_hi > 1000) grid.sync();
  for (int ph = p.ph_lo; ph < p.ph_hi; ++ph) {
    if (ph > p.ph_lo) xcd_barrier(xb);
    int tid = threadIdx.x;
    asm volatile("" : "+v"(tid));
    if (ph == 18) { phase_final(p, tid); continue; }
    const int l = ph / 9, kind = ph % 9;
    switch (kind) {
      case 0:
        if (l == 0) {
          phase_convert_weights(p, smem, tid);
        }
        phase_prep(p, l, smem, tid);
        break;
      case 1: phase_inproj(p, l, smem, tid); if (REPEAT_KIND == 1) phase_inproj(p, l, smem, tid); break;
      case 2: phase_conv_pool(p, l, smem, tid); if (REPEAT_KIND == 20) phase_conv_pool(p, l, smem, tid, 1); if (REPEAT_KIND == 21) phase_conv_pool(p, l, smem, tid, 2); break;
      case 3: phase_chunk_prep(p, l, smem, tid); if (REPEAT_KIND == 3) phase_chunk_prep(p, l, smem, tid); break;
      case 4: phase_scan(p, l, smem, tid); if (REPEAT_KIND == 4) phase_scan(p, l, smem, tid, 2); break;
      case 5:
        phase_onorm(p, l, tid);
        break;
      case 6: phase_merge(p, l, smem, tid); if (REPEAT_KIND == 6) phase_merge(p, l, smem, tid); break;
      case 7: phase_out(p, l, smem, tid); break;
      case 8: phase_gate(p, l, smem, tid); break;
    }
  }
}

extern "C" void kernel_launch(void* const* d_in, const int* in_sizes, int n_in, void* d_out, int out_size, void* d_ws,
                              size_t ws_size, hipStream_t stream) {
  static int grid_blocks = 0;
  if (!grid_blocks) {
    int dev = 0, cus = 0, per_cu = 0;
    hipGetDevice(&dev);
    hipDeviceGetAttribute(&cus, hipDeviceAttributeMultiprocessorCount, dev);
    hipOccupancyMaxActiveBlocksPerMultiprocessor(&per_cu, fwd_megakernel, NT, 0);
    if (per_cu > 2) per_cu = 2;
    if (per_cu < 1) per_cu = 1;
    grid_blocks = cus * per_cu;
  }
  Params p{};
  const float** pp = reinterpret_cast<const float**>(&p);
  for (int i = 0; i < 22; ++i) pp[i] = reinterpret_cast<const float*>(d_in[i]);
  p.out = reinterpret_cast<float*>(d_out);
  p.ws = reinterpret_cast<char*>(d_ws);
  if (ws_size < WS_TOTAL) { fprintf(stderr, "workspace too small: %zu < %zu\n", ws_size, (size_t)WS_TOTAL); return; }
  hipMemsetAsync(p.ws + OFF_BAR, 0, ZERO_BYTES, stream);
#if ONE_LAUNCH
  p.ph_lo = 0; p.ph_hi = 19;
  void* args[] = {&p};
  hipError_t e = hipLaunchCooperativeKernel((void*)fwd_megakernel, dim3(grid_blocks), dim3(NT), args, 0, stream);
  if (e != hipSuccess) fprintf(stderr, "cooperative launch failed: %s (grid %d)\n", hipGetErrorString(e), grid_blocks);
#else
  for (int ph = 0; ph < 19; ++ph) {
    p.ph_lo = ph; p.ph_hi = ph + 1;
    fwd_megakernel<<<dim3(grid_blocks), dim3(NT), 0, stream>>>(p);
  }
#endif
}
```

```cpp
#include <hip/hip_runtime.h>
#include <hip/hip_cooperative_groups.h>
#include <cstdio>
namespace cg = cooperative_groups;

typedef unsigned short u16;
using bf16x8 = __attribute__((ext_vector_type(8))) short;
using f32x4 = __attribute__((ext_vector_type(4))) float;
typedef __bf16 bf16x2_t __attribute__((ext_vector_type(2)));
typedef float f32x2_t __attribute__((ext_vector_type(2)));
#define DI __device__ __forceinline__

#ifndef REPEAT_KIND
#define REPEAT_KIND -1
#endif
#ifndef ONE_LAUNCH
#define ONE_LAUNCH 1
#endif

constexpr int NT = 256;
constexpr int TP = 16384, TS = 512, T = TP + TS;
constexpr int D = 1024, INW = 8208;
constexpr float EPS = 1e-6f;

constexpr size_t SLOT = (size_t)T * 1024 * 2;
constexpr size_t OFF_WIN = 0;
constexpr size_t OFF_WA = OFF_WIN + (size_t)2 * 8192 * 1024 * 2;
constexpr size_t OFF_WB = OFF_WA + (size_t)2 * 1024 * 1024 * 2;
constexpr size_t OFF_WO = OFF_WB + (size_t)2 * 1024 * 1024 * 2;
constexpr size_t OFF_WG = OFF_WO + (size_t)2 * 1024 * 1024 * 2;
constexpr size_t OFF_WP = OFF_WG + (size_t)2 * 1024 * 1024 * 2;
constexpr size_t OFF_WPL = OFF_WP + (size_t)2 * 1024 * 256 * 2;
constexpr size_t OFF_PB = OFF_WPL + (size_t)2 * 4 * 256 * 256 * 2;
constexpr size_t OFF_G = OFF_PB + (size_t)T * 256 * 2;
constexpr size_t OFF_BETA = OFF_G + (size_t)T * 8 * 4;
constexpr size_t OFF_SSQ = OFF_BETA + (size_t)T * 8 * 4;
constexpr size_t OFF_BAR = OFF_SSQ + (size_t)T * 16 * 4;
constexpr size_t OFF_CNT = OFF_BAR + 14336;
constexpr size_t ZERO_BYTES = 14336 + 256;
constexpr size_t OFF_GL = OFF_CNT + 256;
constexpr size_t OFF_P1 = OFF_GL + 2048 * 4;
constexpr size_t OFF_U = OFF_P1 + 3 * SLOT;
constexpr size_t OFF_EXT = OFF_U + SLOT;
constexpr size_t IMG_BYTES = 57344;
constexpr size_t OFF_IMG = OFF_P1;
constexpr size_t OFF_WVT = OFF_IMG + 2048 * IMG_BYTES;
constexpr size_t OFF_H = OFF_EXT + (2048 * IMG_BYTES + 2048 * 16384 - 4 * SLOT) + 256;
constexpr size_t OFF_Z = OFF_H + SLOT;
constexpr size_t OFF_GP = OFF_Z + SLOT;
constexpr size_t OFF_GA = OFF_GP + SLOT;
constexpr size_t OFF_GB = OFF_GA + SLOT;
constexpr size_t OFF_QA = OFF_GB + SLOT;
constexpr size_t OFF_KA = OFF_QA + SLOT;
constexpr size_t OFF_VA = OFF_KA + SLOT;
constexpr size_t OFF_Y = OFF_VA + SLOT;
constexpr size_t WS_TOTAL = OFF_Y + SLOT;
constexpr size_t OFF_OG = OFF_P1, OFF_M = OFF_P1 + 2 * SLOT, OFF_ORAW = OFF_H, OFF_KT = OFF_H;
constexpr size_t OFF_YB_P = OFF_QA, OFF_YB_S = OFF_VA, OFF_PP_P = OFF_KA, OFF_PP_S = OFF_VA + (size_t)TS * 1024 * 2;

constexpr size_t O_Y = 0;
constexpr size_t O_CONVP = (size_t)T * 1024;
constexpr size_t O_DELTAP = O_CONVP + (size_t)2 * 8 * 3 * 3072;
constexpr size_t O_POOLP = O_DELTAP + (size_t)2 * 8 * 8 * 128 * 128;
constexpr size_t O_CONVS = O_POOLP + (size_t)2 * 8 * 15 * 1024;
constexpr size_t O_DELTAS = O_CONVS + (size_t)2 * 128 * 3 * 3072;
constexpr size_t O_POOLS = O_DELTAS + (size_t)2 * 128 * 8 * 128 * 128;

DI u16* ybin_row(char* ws, size_t t) { return reinterpret_cast<u16*>(ws + (t < (size_t)TP ? OFF_YB_P + t * 2048 : OFF_YB_S + (t - TP) * 2048)); }
DI u16* pp_row(char* ws, size_t t) { return reinterpret_cast<u16*>(ws + (t < (size_t)TP ? OFF_PP_P + t * 2048 : OFF_PP_S + (t - TP) * 2048)); }
struct Params {
  const float *x_prompt, *x_sample, *p_prompt, *p_sample, *state_conv, *state_delta, *state_pool, *norm_mix, *w_in,
      *conv_w, *a_log, *dt_bias, *gdn_norm, *w_proj_a, *pool_w, *pool_scale, *w_proj_b, *w_out, *norm_ple, *w_ple_gate,
      *w_ple_proj, *final_norm;
  float* out;
  char* ws;
  int ph_lo, ph_hi;
};

DI unsigned pk2(float a, float b) {
  f32x2_t v = {a, b};
  bf16x2_t r = __builtin_convertvector(v, bf16x2_t);
  return __builtin_bit_cast(unsigned, r);
}
DI float bflo(unsigned u) { return __uint_as_float(u << 16); }
DI float bfhi(unsigned u) { return __uint_as_float(u & 0xffff0000u); }
DI float frcp_(float x) { return __builtin_amdgcn_rcpf(x); }
DI float sigmoidf_(float x) { return frcp_(1.f + __expf(-x)); }
DI float siluf_(float x) { return x * frcp_(1.f + __expf(-x)); }
DI float wave_sum(float v) {
#pragma unroll
  for (int o = 32; o >= 1; o >>= 1) v += __shfl_xor(v, o);
  return v;
}

DI int lds_off(int r, int c) {
  int st = (r >> 4) * 2 + (c >> 5), rr = r & 15, cc = c & 31, ob = rr * 64 + cc * 2;
  return st * 1024 + (ob ^ (((ob >> 9) & 1) << 5));
}

#define XB_TMO      128
#define XB_XCNT(j)  (256  + 64 * (j))
#define XB_XSUB(j)  (1280 + 64 * (j))
#define XB_XGEN(j)  (2304 + 64 * (j))
#define XB_TOP      3328
#define XB_TOPGEN   3392
#define XB_SPIN_CAP (1u << 20)
#define LAS __attribute__((address_space(3)))
DI unsigned xb_ld(unsigned* p) { return __hip_atomic_load(p, __ATOMIC_RELAXED, __HIP_MEMORY_SCOPE_AGENT); }
DI unsigned xb_add(unsigned* p, unsigned v) { return __hip_atomic_fetch_add(p, v, __ATOMIC_RELAXED, __HIP_MEMORY_SCOPE_AGENT); }
DI unsigned xb_xcc_id() { return (unsigned)__builtin_amdgcn_s_getreg((3 << 11) | 20) & 0xFu; }
#define XB_SPIN(cond, bar) do { unsigned _sp = 0; while (cond) { __builtin_amdgcn_s_sleep(1); \
    if ((++_sp & 255u) == 0u) { if (xb_ld(&(bar)[XB_TMO])) break; if (_sp > XB_SPIN_CAP) { atomicAdd(&(bar)[XB_TMO], 1u); break; } } } } while (0)
struct XcdBarrier { unsigned* bar; unsigned x; volatile LAS unsigned* st; };
DI XcdBarrier xcd_barrier_post(unsigned* bar, volatile LAS unsigned* st) {
  XcdBarrier b; b.bar = bar; b.x = xb_xcc_id(); b.st = st;
  if (threadIdx.x == 0) (void)xb_add(&bar[XB_XCNT(b.x)], 1u);
  return b;
}
DI void xcd_barrier_complete(unsigned* bar, unsigned x, unsigned& nloc, unsigned& nx) {
  const unsigned G = gridDim.x * gridDim.y * gridDim.z;
  unsigned sum, cnt, mine, sp = 0u;
  for (;;) {
    sum = 0u; cnt = 0u; mine = 0u;
#pragma unroll
    for (unsigned j = 0; j < 16; ++j) { const unsigned c = xb_ld(&bar[XB_XCNT(j)]); sum += c; cnt += (c > 0u) ? 1u : 0u; mine = (j == x) ? c : mine; }
    if (sum == G) break;
    __builtin_amdgcn_s_sleep(1);
    if ((++sp & 255u) == 0u) { if (xb_ld(&bar[XB_TMO])) break; if (sp > XB_SPIN_CAP) { atomicAdd(&bar[XB_TMO], 1u); break; } }
  }
  nloc = mine > 0u ? mine : 1u; nx = cnt > 0u ? cnt : 1u;
}
DI void xcd_barrier(const XcdBarrier& b) {
  asm volatile("s_waitcnt vmcnt(0)" ::: "memory");
  __syncthreads();
  if (threadIdx.x == 0) {
    unsigned* bar = b.bar;
    __builtin_amdgcn_s_waitcnt(0);
    unsigned nloc = b.st[0], nx = b.st[1];
    if (nloc == 0u) { xcd_barrier_complete(bar, b.x, nloc, nx); b.st[0] = nloc; b.st[1] = nx; }
    const unsigned old = xb_add(&bar[XB_XSUB(b.x)], 1u);
    const unsigned gen = old / nloc;
    if (old + 1u == (gen + 1u) * nloc) {
      __builtin_amdgcn_fence(__ATOMIC_RELEASE, "agent");
      asm volatile("s_waitcnt vmcnt(0)" ::: "memory");
      const unsigned og = xb_add(&bar[XB_TOP], 1u);
      const unsigned tg = og / nx;
      if (og + 1u == (tg + 1u) * nx) xb_add(&bar[XB_TOPGEN], 1u);
      else XB_SPIN(xb_ld(&bar[XB_TOPGEN]) == tg, bar);
      __builtin_amdgcn_fence(__ATOMIC_ACQUIRE, "agent");
      xb_add(&bar[XB_XGEN(b.x)], 1u);
      asm volatile("s_waitcnt vmcnt(0)" ::: "memory");
    } else {
      XB_SPIN(xb_ld(&bar[XB_XGEN(b.x)]) == gen, bar);
      __builtin_amdgcn_fence(__ATOMIC_ACQUIRE, "agent");
      asm volatile("s_waitcnt vmcnt(0)" ::: "memory");
    }
  }
  __syncthreads();
}

DI void gemm_kloop(const u16* __restrict__ A, size_t lda, const u16* __restrict__ Bt, size_t ldb, int K,
                   f32x4 (&acc)[4][4], char* sm, int tid) {
  const int lane = tid & 63, wave = __builtin_amdgcn_readfirstlane(tid >> 6), wm = wave >> 1, wn = wave & 1;
  const int lr = tid >> 2, lkc = tid & 3;
  const u16* Ap = A + (size_t)lr * lda + lkc * 8;
  const u16* Bp = Bt + (size_t)lr * ldb + lkc * 8;
  const int woff0 = lds_off(lr, lkc * 8), woff1 = lds_off(lr + 64, lkc * 8), woff2 = lds_off(lr, 32 + lkc * 8),
            woff3 = lds_off(lr + 64, 32 + lkc * 8);
  int aoff[4][2], boff[4][2];
#pragma unroll
  for (int m = 0; m < 4; ++m)
#pragma unroll
    for (int kk = 0; kk < 2; ++kk) {
      aoff[m][kk] = lds_off(wm * 64 + m * 16 + (lane & 15), kk * 32 + (lane >> 4) * 8);
      boff[m][kk] = lds_off(wn * 64 + m * 16 + (lane & 15), kk * 32 + (lane >> 4) * 8);
    }
  const int nk = K >> 6;
  uint4 pa0, pa1, pa2, pa3, pb0, pb1, pb2, pb3;
  uint4 qa0, qa1, qa2, qa3, qb0, qb1, qb2, qb3;
#define G_LOAD(S, KT)                                                                        \
  {                                                                                          \
    S##a0 = *reinterpret_cast<const uint4*>(Ap + (KT) * 64);                                 \
    S##a1 = *reinterpret_cast<const uint4*>(Ap + (size_t)64 * lda + (KT) * 64);              \
    S##a2 = *reinterpret_cast<const uint4*>(Ap + (KT) * 64 + 32);                            \
    S##a3 = *reinterpret_cast<const uint4*>(Ap + (size_t)64 * lda + (KT) * 64 + 32);         \
    S##b0 = *reinterpret_cast<const uint4*>(Bp + (KT) * 64);                                 \
    S##b1 = *reinterpret_cast<const uint4*>(Bp + (size_t)64 * ldb + (KT) * 64);              \
    S##b2 = *reinterpret_cast<const uint4*>(Bp + (KT) * 64 + 32);                            \
    S##b3 = *reinterpret_cast<const uint4*>(Bp + (size_t)64 * ldb + (KT) * 64 + 32);         \
  }
#define G_STORE(S, BUF)                                                                      \
  {                                                                                          \
    char* da_ = sm + (BUF) * 16384;                                                          \
    *reinterpret_cast<uint4*>(da_ + woff0) = S##a0;                                          \
    *reinterpret_cast<uint4*>(da_ + woff1) = S##a1;                                          \
    *reinterpret_cast<uint4*>(da_ + woff2) = S##a2;                                          \
    *reinterpret_cast<uint4*>(da_ + woff3) = S##a3;                                          \
    *reinterpret_cast<uint4*>(da_ + 32768 + woff0) = S##b0;                                  \
    *reinterpret_cast<uint4*>(da_ + 32768 + woff1) = S##b1;                                  \
    *reinterpret_cast<uint4*>(da_ + 32768 + woff2) = S##b2;                                  \
    *reinterpret_cast<uint4*>(da_ + 32768 + woff3) = S##b3;                                  \
  }
#define G_COMPUTE(BUF)                                                                       \
  {                                                                                          \
    const char* sa = sm + (BUF) * 16384;                                                     \
    const char* sb = sm + 32768 + (BUF) * 16384;                                             \
    _Pragma("unroll") for (int kk = 0; kk < 2; ++kk) {                                       \
      bf16x8 af[4], bfr[4];                                                                  \
      _Pragma("unroll") for (int m = 0; m < 4; ++m) af[m] = *reinterpret_cast<const bf16x8*>(sa + aoff[m][kk]);  \
      _Pragma("unroll") for (int n = 0; n < 4; ++n) bfr[n] = *reinterpret_cast<const bf16x8*>(sb + boff[n][kk]); \
      _Pragma("unroll") for (int m = 0; m < 4; ++m)                                          \
        _Pragma("unroll") for (int n = 0; n < 4; ++n)                                        \
          acc[m][n] = __builtin_amdgcn_mfma_f32_16x16x32_bf16(bfr[n], af[m], acc[m][n], 0, 0, 0);                \
    }                                                                                        \
  }
  const int nkm1 = nk - 1;
  G_LOAD(p, 0)
  G_STORE(p, 0)
  G_LOAD(p, 1)
  __builtin_amdgcn_sched_barrier(0);
  G_LOAD(q, min(2, nkm1))
  __builtin_amdgcn_sched_barrier(0);
  __syncthreads();
  for (int kt = 0; kt < nk; kt += 2) {
    G_COMPUTE(0)
    G_STORE(p, 1)
    G_LOAD(p, min(kt + 3, nkm1))
    __syncthreads();
    G_COMPUTE(1)
    G_STORE(q, 0)
    G_LOAD(q, min(kt + 4, nkm1))
    __syncthreads();
  }
}

#define GREGS_DECL uint4 g_pa0, g_pa1, g_pa2, g_pa3, g_pb0, g_pb1, g_pb2, g_pb3, g_qa0, g_qa1, g_qa2, g_qa3, g_qb0, g_qb1, g_qb2, g_qb3
#define GREGS_PARAMS uint4 &g_pa0, uint4 &g_pa1, uint4 &g_pa2, uint4 &g_pa3, uint4 &g_pb0, uint4 &g_pb1, uint4 &g_pb2, uint4 &g_pb3, uint4 &g_qa0, uint4 &g_qa1, uint4 &g_qa2, uint4 &g_qa3, uint4 &g_qb0, uint4 &g_qb1, uint4 &g_qb2, uint4 &g_qb3
#define GREGS_ARGS g_pa0, g_pa1, g_pa2, g_pa3, g_pb0, g_pb1, g_pb2, g_pb3, g_qa0, g_qa1, g_qa2, g_qa3, g_qb0, g_qb1, g_qb2, g_qb3
DI void gemm_stream(const u16* __restrict__ A, const u16* __restrict__ Bt, const u16* __restrict__ An,
                    const u16* __restrict__ Btn, size_t lda, size_t ldb, int K, bool first, f32x4 (&acc)[4][4], GREGS_PARAMS,
                    char* sm, int tid) {
  const int lane = tid & 63, wave = __builtin_amdgcn_readfirstlane(tid >> 6), wm = wave >> 1, wn = wave & 1;
  const int lr = tid >> 2, lkc = tid & 3;
  const u16* Ap = A + (size_t)lr * lda + lkc * 8;
  const u16* Bp = Bt + (size_t)lr * ldb + lkc * 8;
  const u16* Apn = An + (size_t)lr * lda + lkc * 8;
  const u16* Bpn = Btn + (size_t)lr * ldb + lkc * 8;
  const int woff0 = lds_off(lr, lkc * 8), woff1 = lds_off(lr + 64, lkc * 8), woff2 = lds_off(lr, 32 + lkc * 8),
            woff3 = lds_off(lr + 64, 32 + lkc * 8);
  int aoff[4][2], boff[4][2];
#pragma unroll
  for (int m = 0; m < 4; ++m)
#pragma unroll
    for (int kk = 0; kk < 2; ++kk) {
      aoff[m][kk] = lds_off(wm * 64 + m * 16 + (lane & 15), kk * 32 + (lane >> 4) * 8);
      boff[m][kk] = lds_off(wn * 64 + m * 16 + (lane & 15), kk * 32 + (lane >> 4) * 8);
    }
  const int nk = K >> 6;
#define S_LOAD(S, IDX)                                                                       \
  {                                                                                          \
    const int ix_ = (IDX);                                                                   \
    const u16* a_ = ix_ < nk ? Ap + ix_ * 64 : Apn + (ix_ - nk) * 64;                        \
    const u16* b_ = ix_ < nk ? Bp + ix_ * 64 : Bpn + (ix_ - nk) * 64;                        \
    g_##S##a0 = *reinterpret_cast<const uint4*>(a_);                                           \
    g_##S##a1 = *reinterpret_cast<const uint4*>(a_ + (size_t)64 * lda);                        \
    g_##S##a2 = *reinterpret_cast<const uint4*>(a_ + 32);                                      \
    g_##S##a3 = *reinterpret_cast<const uint4*>(a_ + (size_t)64 * lda + 32);                   \
    g_##S##b0 = *reinterpret_cast<const uint4*>(b_);                                           \
    g_##S##b1 = *reinterpret_cast<const uint4*>(b_ + (size_t)64 * ldb);                        \
    g_##S##b2 = *reinterpret_cast<const uint4*>(b_ + 32);                                      \
    g_##S##b3 = *reinterpret_cast<const uint4*>(b_ + (size_t)64 * ldb + 32);                   \
  }
#define S_STORE(S, BUF)                                                                      \
  {                                                                                          \
    char* da_ = sm + (BUF) * 16384;                                                          \
    *reinterpret_cast<uint4*>(da_ + woff0) = g_##S##a0;                                        \
    *reinterpret_cast<uint4*>(da_ + woff1) = g_##S##a1;                                        \
    *reinterpret_cast<uint4*>(da_ + woff2) = g_##S##a2;                                        \
    *reinterpret_cast<uint4*>(da_ + woff3) = g_##S##a3;                                        \
    *reinterpret_cast<uint4*>(da_ + 32768 + woff0) = g_##S##b0;                                \
    *reinterpret_cast<uint4*>(da_ + 32768 + woff1) = g_##S##b1;                                \
    *reinterpret_cast<uint4*>(da_ + 32768 + woff2) = g_##S##b2;                                \
    *reinterpret_cast<uint4*>(da_ + 32768 + woff3) = g_##S##b3;                                \
  }
  if (first) {
    S_LOAD(p, 0)
    S_STORE(p, 0)
    S_LOAD(p, 1)
    __builtin_amdgcn_sched_barrier(0);
    S_LOAD(q, 2)
    __builtin_amdgcn_sched_barrier(0);
    __syncthreads();
  }
  for (int kt = 0; kt < nk; kt += 2) {
    G_COMPUTE(0)
    S_STORE(p, 1)
    S_LOAD(p, kt + 3)
    __syncthreads();
    G_COMPUTE(1)
    S_STORE(q, 0)
    S_LOAD(q, kt + 4)
    __syncthreads();
  }
}

DI void glds16(const u16* g, char* l) {
  __builtin_amdgcn_global_load_lds(reinterpret_cast<const unsigned*>(g), reinterpret_cast<unsigned*>(l), 16, 0, 0);
}
DI void gemm_dma(const u16* __restrict__ A, const u16* __restrict__ Bt, const u16* __restrict__ An,
                 const u16* __restrict__ Btn, size_t lda, size_t ldb, int K, bool first, f32x4 (&acc)[4][4], char* sm,
                 int tid) {
  const int lane = tid & 63, wave = __builtin_amdgcn_readfirstlane(tid >> 6), wm = wave >> 1, wn = wave & 1;
  const int sb = lane * 16, swz = sb ^ (((sb >> 9) & 1) << 5);
  const int R0 = (wave >> 1) * 16 + (swz >> 6), C = (wave & 1) * 32 + ((swz & 63) >> 1);
  const u16* Ap = A + (size_t)R0 * lda + C;
  const u16* Bp = Bt + (size_t)R0 * ldb + C;
  const u16* Apn = An + (size_t)R0 * lda + C;
  const u16* Bpn = Btn + (size_t)R0 * ldb + C;
  char* l0 = sm + tid * 16;
  int aoff[4][2], boff[4][2];
#pragma unroll
  for (int m = 0; m < 4; ++m)
#pragma unroll
    for (int kk = 0; kk < 2; ++kk) {
      aoff[m][kk] = lds_off(wm * 64 + m * 16 + (lane & 15), kk * 32 + (lane >> 4) * 8);
      boff[m][kk] = lds_off(wn * 64 + m * 16 + (lane & 15), kk * 32 + (lane >> 4) * 8);
    }
  const int nk = K >> 6;
#define D_LOAD(IDX, BUF)                                                                     \
  {                                                                                          \
    const int ix_ = (IDX);                                                                   \
    const u16* a_ = ix_ < nk ? Ap + ix_ * 64 : Apn;                                          \
    const u16* b_ = ix_ < nk ? Bp + ix_ * 64 : Bpn;                                          \
    char* la_ = l0 + (BUF) * 16384;                                                          \
    glds16(a_, la_);                                                                         \
    glds16(a_ + (size_t)32 * lda, la_ + 4096);                                               \
    glds16(a_ + (size_t)64 * lda, la_ + 8192);                                               \
    glds16(a_ + (size_t)96 * lda, la_ + 12288);                                              \
    glds16(b_, la_ + 32768);                                                                 \
    glds16(b_ + (size_t)32 * ldb, la_ + 32768 + 4096);                                       \
    glds16(b_ + (size_t)64 * ldb, la_ + 32768 + 8192);                                       \
    glds16(b_ + (size_t)96 * ldb, la_ + 32768 + 12288);                                      \
  }
#define D_STEP(BUF, IDX, NBUF)                                                               \
  {                                                                                          \
    const char* sa = sm + (BUF) * 16384;                                                     \
    const char* sb = sm + 32768 + (BUF) * 16384;                                             \
    bf16x8 af[2][4], bfr[2][4];                                                              \
    __builtin_amdgcn_s_setprio(2);        \
    _Pragma("unroll") for (int kk = 0; kk < 2; ++kk) {                                       \
      _Pragma("unroll") for (int m = 0; m < 4; ++m) af[kk][m] = *reinterpret_cast<const bf16x8*>(sa + aoff[m][kk]);  \
      _Pragma("unroll") for (int n = 0; n < 4; ++n) bfr[kk][n] = *reinterpret_cast<const bf16x8*>(sb + boff[n][kk]); \
    }                                                                                        \
    __builtin_amdgcn_sched_barrier(0);                                                       \
    D_LOAD(IDX, NBUF)                                                                        \
    __builtin_amdgcn_s_setprio(0);                                                           \
    __builtin_amdgcn_sched_barrier(0);                                                       \
    _Pragma("unroll") for (int kk = 0; kk < 2; ++kk)                                         \
      _Pragma("unroll") for (int m = 0; m < 4; ++m)                                          \
        _Pragma("unroll") for (int n = 0; n < 4; ++n)                                        \
          acc[m][n] = __builtin_amdgcn_mfma_f32_16x16x32_bf16(bfr[kk][n], af[kk][m], acc[m][n], 0, 0, 0);           \
    __builtin_amdgcn_sched_barrier(0);    \
  }
  if (first) {
    D_LOAD(0, 0)
    __syncthreads();
  }
  for (int kt = 0; kt < nk; kt += 2) {
    D_STEP(0, kt + 1, 1)
    __syncthreads();
    D_STEP(1, kt + 2, 0)
    __syncthreads();
  }
}

DI void acc_zero(f32x4 (&acc)[4][4]) {
#pragma unroll
  for (int m = 0; m < 4; ++m)
#pragma unroll
    for (int n = 0; n < 4; ++n) acc[m][n] = f32x4{0.f, 0.f, 0.f, 0.f};
}

#define EPI_LOOP(BODY)                                                                   \
  {                                                                                      \
    const int lane_ = tid & 63, wave_ = __builtin_amdgcn_readfirstlane(tid >> 6), wm_ = wave_ >> 1, wn_ = wave_ & 1;     \
    _Pragma("unroll") for (int m = 0; m < 4; ++m) {                                      \
      const int row = wm_ * 64 + m * 16 + (lane_ & 15);                                  \
      _Pragma("unroll") for (int n = 0; n < 4; ++n) {                                    \
        const int col = wn_ * 64 + n * 16 + (lane_ >> 4) * 4;                            \
        f32x4& v = acc[m][n];                                                            \
        BODY                                                                             \
      }                                                                                  \
    }                                                                                    \
  }

DI void store_bf4(u16* p, float a, float b, float c, float d) {
  uint2 u;
  u.x = pk2(a, b);
  u.y = pk2(c, d);
  *reinterpret_cast<uint2*>(p) = u;
}

#define XCD_TILE_LOOP(MT, NT8)                                                                        \
  const int xcd_ = blockIdx.x & 7, slot_ = blockIdx.x >> 3, nslots_ = gridDim.x >> 3;                 \
  const int mlo_ = (xcd_ * 132) >> 3, mhi_ = ((xcd_ + 1) * 132) >> 3;                                 \
  for (int it_ = slot_, MT = mlo_ + (slot_ >> 3), NT8 = slot_ & 7; it_ < (mhi_ - mlo_) * 8;           \
       it_ += nslots_, MT = mlo_ + (it_ >> 3), NT8 = it_ & 7)

#define XCD_TILE_LOOP_N(MT, NT8, MTN, NTN)                                                            \
  const int xcd_ = blockIdx.x & 7, slot_ = blockIdx.x >> 3, nslots_ = gridDim.x >> 3;                 \
  const int mlo_ = (xcd_ * 132) >> 3, mhi_ = ((xcd_ + 1) * 132) >> 3, lim_ = (mhi_ - mlo_) * 8;        \
  for (int it_ = slot_, itn_ = (slot_ + nslots_ < lim_ ? slot_ + nslots_ : slot_), MT = mlo_ + (it_ >> 3), NT8 = it_ & 7, \
           MTN = mlo_ + (itn_ >> 3), NTN = itn_ & 7;                                                  \
       it_ < lim_;                                                                                    \
       it_ += nslots_, itn_ = (it_ + nslots_ < lim_ ? it_ + nslots_ : it_), MT = mlo_ + (it_ >> 3), NT8 = it_ & 7, \
           MTN = mlo_ + (itn_ >> 3), NTN = itn_ & 7)

DI void convT_tile(const float* __restrict__ src, int ldsrc, int k0, int srccol0, u16* __restrict__ dst, int K,
                   int dstn0, const float* __restrict__ scale, float* sm, int tid) {
  float vv[16];
#pragma unroll
  for (int i = 0; i < 16; ++i) {
    const int k = i * 4 + (tid >> 6);
    float v = src[(size_t)(k0 + k) * ldsrc + srccol0 + (tid & 63)];
    if (scale) v *= scale[k0 + k];
    vv[i] = v;
  }
#pragma unroll
  for (int i = 0; i < 16; ++i) sm[(i * 4 + (tid >> 6)) * 65 + (tid & 63)] = vv[i];
  __syncthreads();
#pragma unroll
  for (int ps = 0; ps < 2; ++ps) {
    const int n = ps * 32 + (tid >> 3), kc = tid & 7;
    const float* c = sm + (kc * 8) * 65 + n;
    uint4 u;
    u.x = pk2(c[0], c[65]); u.y = pk2(c[2 * 65], c[3 * 65]); u.z = pk2(c[4 * 65], c[5 * 65]); u.w = pk2(c[6 * 65], c[7 * 65]);
    *reinterpret_cast<uint4*>(dst + (size_t)(dstn0 + n) * K + k0 + kc * 8) = u;
  }
  __syncthreads();
}

__device__ void phase_convert_weights(const Params& p, char* smem, int tid) {
  float* sm = reinterpret_cast<float*>(smem);
  for (int it = blockIdx.x; it < 6400; it += gridDim.x) {
    if (it < 4096) {
      int l = it >> 11, r = it & 2047, kt = r >> 7, nt = r & 127;
      int n0 = nt * 64;
      int srccol = n0 < 4096 ? n0 : n0 + 16;
      convT_tile(p.w_in + (size_t)l * 1024 * INW, INW, kt * 64, srccol,
                 reinterpret_cast<u16*>(p.ws + OFF_WIN) + (size_t)l * 8192 * 1024, 1024, n0, p.norm_mix + l * 1024, sm,
                 tid);
    } else if (it < 6144) {
      int r = it - 4096, which = r >> 9, l = (r >> 8) & 1, tt = r & 255, kt = tt >> 4, nt = tt & 15;
      const float* src = which == 0 ? p.w_proj_a : which == 1 ? p.w_proj_b : which == 2 ? p.w_out : p.w_ple_gate;
      size_t off = which == 0 ? OFF_WA : which == 1 ? OFF_WB : which == 2 ? OFF_WO : OFF_WG;
      convT_tile(src + (size_t)l * 1024 * 1024, 1024, kt * 64, nt * 64,
                 reinterpret_cast<u16*>(p.ws + off) + (size_t)l * 1024 * 1024, 1024, nt * 64,
                 which == 3 ? p.norm_ple + l * 1024 : nullptr, sm, tid);
    } else if (it < 6272) {
      int r = it - 6144, l = r >> 6, tt = r & 63, kt = tt >> 4, nt = tt & 15;
      convT_tile(p.w_ple_proj + (size_t)l * 256 * 1024, 1024, kt * 64, nt * 64,
                 reinterpret_cast<u16*>(p.ws + OFF_WP) + (size_t)l * 1024 * 256, 256, nt * 64, nullptr, sm, tid);
    } else {
      int r = it - 6272, lg = r >> 4, tt = r & 15, kt = tt >> 2, nt = tt & 3;
      convT_tile(p.pool_w + (size_t)lg * 256 * 256, 256, kt * 64, nt * 64,
                 reinterpret_cast<u16*>(p.ws + OFF_WPL) + (size_t)lg * 256 * 256, 256, nt * 64, nullptr, sm, tid);
    }
  }
}

__device__ void phase_prep(const Params& p, int l, char* smem, int tid) {
  float* sW = reinterpret_cast<float*>(smem);
  const float* win = p.w_in + (size_t)l * 1024 * INW;
  const float* nm = p.norm_mix + l * 1024;
  for (int i = 0; i < 64; ++i) {
    int idx = tid + 256 * i;
    int k = idx >> 4, j = idx & 15;
    sW[j * 1024 + k] = win[(size_t)k * INW + 4096 + j] * nm[k];
  }
  __syncthreads();
  const int lane = tid & 63, wave = __builtin_amdgcn_readfirstlane(tid >> 6);
  u16* hb = reinterpret_cast<u16*>(p.ws + OFF_H);
  u16* pb = reinterpret_cast<u16*>(p.ws + OFF_PB);
  float* gbuf = reinterpret_cast<float*>(p.ws + OFF_G);
  float* bbuf = reinterpret_cast<float*>(p.ws + OFF_BETA);
  auto rowptr = [&](int r) -> const float* {
    if (l == 0) return r < TP ? p.x_prompt + (size_t)r * 1024 : p.x_sample + (size_t)(r - TP) * 1024;
    return p.out + (size_t)r * 1024;
  };
  int r = blockIdx.x * 4 + wave;
  float4 xn0 = {0.f, 0.f, 0.f, 0.f}, xn1 = xn0, xn2 = xn0, xn3 = xn0;
  if (r < T) {
    const float* xr = rowptr(r);
    xn0 = *reinterpret_cast<const float4*>(xr + lane * 4);
    xn1 = *reinterpret_cast<const float4*>(xr + 256 + lane * 4);
    xn2 = *reinterpret_cast<const float4*>(xr + 512 + lane * 4);
    xn3 = *reinterpret_cast<const float4*>(xr + 768 + lane * 4);
  }
  for (; r < T; r += gridDim.x * 4) {
    float4 xv[4] = {xn0, xn1, xn2, xn3};
    const float* prow = r < TP ? p.p_prompt + ((size_t)l * TP + r) * 256 : p.p_sample + ((size_t)l * TS + (r - TP)) * 256;
    const float4 pv = *reinterpret_cast<const float4*>(prow + lane * 4);
    const int rn = r + gridDim.x * 4;
    if (rn < T) {
      const float* xr = rowptr(rn);
      xn0 = *reinterpret_cast<const float4*>(xr + lane * 4);
      xn1 = *reinterpret_cast<const float4*>(xr + 256 + lane * 4);
      xn2 = *reinterpret_cast<const float4*>(xr + 512 + lane * 4);
      xn3 = *reinterpret_cast<const float4*>(xr + 768 + lane * 4);
    }
    float ss = 0.f;
#pragma unroll
    for (int i = 0; i < 4; ++i) ss += xv[i].x * xv[i].x + xv[i].y * xv[i].y + xv[i].z * xv[i].z + xv[i].w * xv[i].w;
    float d[16];
#pragma unroll
    for (int j = 0; j < 16; ++j) d[j] = 0.f;
#pragma unroll
    for (int i = 0; i < 4; ++i) {
#pragma unroll
      for (int j = 0; j < 16; ++j) {
        float4 w = *reinterpret_cast<const float4*>(sW + j * 1024 + i * 256 + lane * 4);
        d[j] += xv[i].x * w.x + xv[i].y * w.y + xv[i].z * w.z + xv[i].w * w.w;
      }
      __builtin_amdgcn_sched_barrier(0);
    }
    ss = wave_sum(ss);
    float k8[8], k4[4], k2[2], k1;
#pragma unroll
    for (int i = 0; i < 8; ++i) {
      const float send = (lane & 32) ? d[i] : d[i + 8], keep = (lane & 32) ? d[i + 8] : d[i];
      k8[i] = keep + __shfl_xor(send, 32);
    }
#pragma unroll
    for (int i = 0; i < 4; ++i) {
      const float send = (lane & 16) ? k8[i] : k8[i + 4], keep = (lane & 16) ? k8[i + 4] : k8[i];
      k4[i] = keep + __shfl_xor(send, 16);
    }
#pragma unroll
    for (int i = 0; i < 2; ++i) {
      const float send = (lane & 8) ? k4[i] : k4[i + 2], keep = (lane & 8) ? k4[i + 2] : k4[i];
      k2[i] = keep + __shfl_xor(send, 8);
    }
    {
      const float send = (lane & 4) ? k2[0] : k2[1], keep = (lane & 4) ? k2[1] : k2[0];
      k1 = keep + __shfl_xor(send, 4);
    }
    k1 += __shfl_xor(k1, 2);
    k1 += __shfl_xor(k1, 1);
    const float rstd = rsqrtf(ss * (1.f / 1024.f) + EPS);
#pragma unroll
    for (int i = 0; i < 4; ++i)
      store_bf4(hb + (size_t)r * 1024 + i * 256 + lane * 4, xv[i].x * rstd, xv[i].y * rstd, xv[i].z * rstd, xv[i].w * rstd);
    if ((lane & 3) == 0) {
      const int j = ((lane >> 5) & 1) * 8 + ((lane >> 4) & 1) * 4 + ((lane >> 3) & 1) * 2 + ((lane >> 2) & 1);
      const float val = k1 * rstd;
      if (j < 8) {
        float xx = val + p.dt_bias[l * 8 + j];
        float sp = xx > 20.f ? xx : log1pf(__expf(xx));
        gbuf[(size_t)r * 8 + j] = -__expf(p.a_log[l * 8 + j]) * sp;
      } else {
        bbuf[(size_t)r * 8 + (j - 8)] = sigmoidf_(val);
      }
    }
    store_bf4(pb + (size_t)r * 256 + lane * 4, pv.x, pv.y, pv.z, pv.w);
  }
}

__device__ void phase_final(const Params& p, int tid) {
  const int lane = tid & 63, wave = __builtin_amdgcn_readfirstlane(tid >> 6);
  for (int r = blockIdx.x * 4 + wave; r < T; r += gridDim.x * 4) {
    float* xrow = p.out + (size_t)r * 1024;
    float4 xv[4];
    float ss = 0.f;
#pragma unroll
    for (int i = 0; i < 4; ++i) {
      xv[i] = *reinterpret_cast<const float4*>(xrow + i * 256 + lane * 4);
      ss += xv[i].x * xv[i].x + xv[i].y * xv[i].y + xv[i].z * xv[i].z + xv[i].w * xv[i].w;
    }
    ss = wave_sum(ss);
    const float rstd = rsqrtf(ss * (1.f / 1024.f) + EPS);
#pragma unroll
    for (int i = 0; i < 4; ++i) {
      float4 w = *reinterpret_cast<const float4*>(p.final_norm + i * 256 + lane * 4);
      float4 o;
      o.x = xv[i].x * rstd * w.x; o.y = xv[i].y * rstd * w.y; o.z = xv[i].z * rstd * w.z; o.w = xv[i].w * rstd * w.w;
      *reinterpret_cast<float4*>(xrow + i * 256 + lane * 4) = o;
    }
  }
}

__device__ void phase_inproj(const Params& p, int l, char* smem, int tid) {
  const u16* hb = reinterpret_cast<const u16*>(p.ws + OFF_H);
  const u16* W = reinterpret_cast<const u16*>(p.ws + OFF_WIN) + (size_t)l * 8192 * 1024;
  u16* P1 = reinterpret_cast<u16*>(p.ws + OFF_P1);
  const int xcd = blockIdx.x & 7, slot = blockIdx.x >> 3, nslots = gridDim.x >> 3;
  GREGS_DECL;
  bool first = true;
  for (int it = slot; it < 132 * 8; it += nslots) {
    const int mt = it >> 3, nt = xcd * 8 + (it & 7);
    const int itn = (it + nslots < 132 * 8) ? it + nslots : it;
    const int mtn = itn >> 3, ntn = xcd * 8 + (itn & 7);
    f32x4 acc[4][4];
    acc_zero(acc);
    gemm_dma(hb + (size_t)mt * 128 * 1024, W + (size_t)nt * 128 * 1024, hb + (size_t)mtn * 128 * 1024,
                W + (size_t)ntn * 128 * 1024, 1024, 1024, 1024, first, acc, smem, tid);
    first = false;
    u16* dst;
    size_t ld;
    if (nt < 24) { dst = P1 + (size_t)mt * 128 * 3072 + nt * 128; ld = 3072; }
    else {
      const int arr = (nt - 24) >> 3;
      const size_t off = arr == 0 ? OFF_Z : arr == 1 ? OFF_U : arr == 2 ? OFF_GP : arr == 3 ? OFF_GA : OFF_GB;
      dst = reinterpret_cast<u16*>(p.ws + off) + (size_t)mt * 128 * 1024 + ((nt - 24) & 7) * 128; ld = 1024;
    }
    EPI_LOOP({ store_bf4(dst + (size_t)row * ld + col, v[0], v[1], v[2], v[3]); })
  }
}

__device__ void phase_conv_pool(const Params& p, int l, char* smem, int tid, int mode = 3) {
  const int lane = tid & 63, wave = __builtin_amdgcn_readfirstlane(tid >> 6);
  const u16* P1 = reinterpret_cast<const u16*>(p.ws + OFF_P1);
  const u16* Ub = reinterpret_cast<const u16*>(p.ws + OFF_U);
  u16* ypre = reinterpret_cast<u16*>(p.ws + OFF_Y);
  const int n_prompt = 256 * 24;
  const int n_conv = n_prompt + 128 * 24;
  if (mode & 1)
  for (int wt = blockIdx.x * 4 + wave; wt < n_conv; wt += gridDim.x * 4) {
    const bool smp = wt >= n_prompt;
    int run, j;
    if (!smp) { run = wt / 24; j = wt % 24; } else { run = (wt - n_prompt) / 24; j = (wt - n_prompt) % 24; }
    const int col = j * 128 + lane * 2;
    const int hh = j & 7, ten = j >> 3;
    const float* cw = p.conv_w + (size_t)l * 4 * 3072 + col;
    const float2 w0 = *reinterpret_cast<const float2*>(cw);
    const float2 w1 = *reinterpret_cast<const float2*>(cw + 3072);
    const float2 w2 = *reinterpret_cast<const float2*>(cw + 2 * 3072);
    const float2 w3 = *reinterpret_cast<const float2*>(cw + 3 * 3072);
    u16* tokmaj = reinterpret_cast<u16*>(p.ws + (ten == 0 ? OFF_QA : ten == 1 ? OFF_KA : OFF_VA));
    float2 x0 = {0.f, 0.f}, x1 = {0.f, 0.f}, x2 = {0.f, 0.f};
    if (!smp) {
      const int b = run >> 5, t0 = (run & 31) * 64;
      const int ts = lane >> 4, c8 = lane & 15;
      const int seg0 = t0 + ts * 16;
      const size_t rowb = (size_t)b * 2048 + seg0;
      const int col8 = j * 128 + c8 * 8;
      char* stg = smem + wave * 16384;
      float wc[4][8];
#pragma unroll
      for (int r = 0; r < 4; ++r) {
        const float4 wa = *reinterpret_cast<const float4*>(p.conv_w + (size_t)l * 4 * 3072 + r * 3072 + col8);
        const float4 wb = *reinterpret_cast<const float4*>(p.conv_w + (size_t)l * 4 * 3072 + r * 3072 + col8 + 4);
        wc[r][0] = wa.x; wc[r][1] = wa.y; wc[r][2] = wa.z; wc[r][3] = wa.w;
        wc[r][4] = wb.x; wc[r][5] = wb.y; wc[r][6] = wb.z; wc[r][7] = wb.w;
      }
      const u16* src = P1 + rowb * 3072 + col8;
      float xw[3][8];
      {
        uint4 h0 = {0u, 0u, 0u, 0u}, h1 = h0, h2 = h0;
        if (seg0 > 0) {
          h0 = *reinterpret_cast<const uint4*>(src - (size_t)3 * 3072);
          h1 = *reinterpret_cast<const uint4*>(src - (size_t)2 * 3072);
          h2 = *reinterpret_cast<const uint4*>(src - (size_t)1 * 3072);
        }
#define UNPK8(DST, U) { DST[0] = bflo(U.x); DST[1] = bfhi(U.x); DST[2] = bflo(U.y); DST[3] = bfhi(U.y); \
                        DST[4] = bflo(U.z); DST[5] = bfhi(U.z); DST[6] = bflo(U.w); DST[7] = bfhi(U.w); }
        UNPK8(xw[0], h0) UNPK8(xw[1], h1) UNPK8(xw[2], h2)
      }
      uint4 rall[16];
#pragma unroll
      for (int i = 0; i < 16; ++i) rall[i] = *reinterpret_cast<const uint4*>(src + (size_t)i * 3072);
#pragma unroll
      for (int qb = 0; qb < 4; ++qb) {
        uint4 rows[4];
#pragma unroll
        for (int i = 0; i < 4; ++i) rows[i] = rall[qb * 4 + i];
        float o[4][8];
        float ss[4];
#pragma unroll
        for (int i = 0; i < 4; ++i) {
          float x3[8];
          UNPK8(x3, rows[i])
          float sacc = 0.f;
#pragma unroll
          for (int c = 0; c < 8; ++c) {
            float v = xw[0][c] * wc[0][c] + xw[1][c] * wc[1][c] + xw[2][c] * wc[2][c] + x3[c] * wc[3][c];
            v = siluf_(v);
            o[i][c] = v;
            sacc += v * v;
            xw[0][c] = xw[1][c]; xw[1][c] = xw[2][c]; xw[2][c] = x3[c];
          }
          ss[i] = sacc;
          const int tseq = seg0 + qb * 4 + i;
          if (tseq >= 2045) {
            float* po = p.out + O_CONVP + ((size_t)(l * 8 + b) * 3 + (tseq - 2045)) * 3072 + col8;
            *reinterpret_cast<float4*>(po) = float4{x3[0], x3[1], x3[2], x3[3]};
            *reinterpret_cast<float4*>(po + 4) = float4{x3[4], x3[5], x3[6], x3[7]};
          }
        }
        if (ten < 2) {
#pragma unroll
          for (int ofs = 8; ofs >= 1; ofs >>= 1) {
#pragma unroll
            for (int i = 0; i < 4; ++i) ss[i] += __shfl_xor(ss[i], ofs);
          }
#pragma unroll
          for (int i = 0; i < 4; ++i) {
            float sc = rsqrtf(ss[i] + EPS);
            if (ten == 0) sc *= 0.08838834764831845f;
#pragma unroll
            for (int c = 0; c < 8; ++c) o[i][c] *= sc;
            uint4 w;
            w.x = pk2(o[i][0], o[i][1]); w.y = pk2(o[i][2], o[i][3]); w.z = pk2(o[i][4], o[i][5]); w.w = pk2(o[i][6], o[i][7]);
            *reinterpret_cast<uint4*>(tokmaj + (rowb + qb * 4 + i) * 1024 + hh * 128 + c8 * 8) = w;
          }
        }
        if (ten >= 1) {
          const int chunk8 = ts * 4 + qb;
#pragma unroll
          for (int c = 0; c < 8; ++c) {
            const int ch = c8 * 8 + c;
            uint2 w;
            w.x = pk2(o[0][c], o[1][c]); w.y = pk2(o[2][c], o[3][c]);
            *reinterpret_cast<uint2*>(stg + ch * 128 + (((chunk8 >> 1) ^ (c8 & 7)) * 16) + (chunk8 & 1) * 8) = w;
          }
        }
        __builtin_amdgcn_sched_barrier(0);
      }
      if (ten >= 1) {
        asm volatile("s_waitcnt lgkmcnt(0)" ::: "memory");
        u16* tr = reinterpret_cast<u16*>(p.ws + (ten == 1 ? OFF_KT : OFF_VA)) + ((size_t)(b * 8 + hh) * 128) * 2048 + t0;
#pragma unroll 4
        for (int k = 0; k < 16; ++k) {
          const int pc = lane + 64 * k, ch = pc >> 3, c = pc & 7;
          const uint4 v = *reinterpret_cast<const uint4*>(stg + ch * 128 + ((c ^ ((ch >> 3) & 7)) * 16));
          *reinterpret_cast<uint4*>(tr + (unsigned)(ch * 2048 + c * 8)) = v;
        }
        asm volatile("s_waitcnt lgkmcnt(0)" ::: "memory");
      }
    } else {
      const int b = run, base = TP + b * 4;
      const float* sc0 = p.state_conv + ((size_t)(l * 128 + b) * 3) * 3072 + col;
      x0 = *reinterpret_cast<const float2*>(sc0);
      x1 = *reinterpret_cast<const float2*>(sc0 + 3072);
      x2 = *reinterpret_cast<const float2*>(sc0 + 2 * 3072);
      unsigned ur[4];
#pragma unroll
      for (int i = 0; i < 4; ++i) ur[i] = *reinterpret_cast<const unsigned*>(P1 + (size_t)(base + i) * 3072 + col);
#pragma unroll
      for (int i = 0; i < 4; ++i) {
        unsigned u3 = ur[i];
        float2 x3 = {bflo(u3), bfhi(u3)};
        float oa = x0.x * w0.x + x1.x * w1.x + x2.x * w2.x + x3.x * w3.x;
        float ob = x0.y * w0.y + x1.y * w1.y + x2.y * w2.y + x3.y * w3.y;
        oa = siluf_(oa); ob = siluf_(ob);
        if (ten < 2) {
          float ss = wave_sum(oa * oa + ob * ob);
          float sc = rsqrtf(ss + EPS);
          if (ten == 0) sc *= 0.08838834764831845f;
          oa *= sc; ob *= sc;
        }
        *reinterpret_cast<unsigned*>(tokmaj + (size_t)(base + i) * 1024 + hh * 128 + lane * 2) = pk2(oa, ob);
        if (i >= 1)
          *reinterpret_cast<float2*>(p.out + O_CONVS + ((size_t)(l * 128 + b) * 3 + (i - 1)) * 3072 + col) = x3;
        x0 = x1; x1 = x2; x2 = x3;
      }
    }
  }
  const int col = tid * 4;
  const int win = 2 << wave;
  if (mode & 2)
  for (int bt = blockIdx.x; bt < 64 + 512; bt += gridDim.x) {
    if (bt < 64) {
      for (int i = 0; i < 8; ++i) {
        const int tt = TP + bt * 8 + i;
        const int sb = (tt - TP) >> 2, t = (tt - TP) & 3;
        const float* sp = p.state_pool + ((size_t)(l * 128 + sb) * 15) * 1024 + col;
        float s0 = 0.f, s1 = 0.f, s2 = 0.f, s3 = 0.f;
        float4 ut = {0.f, 0.f, 0.f, 0.f};
#pragma unroll
        for (int k = 0; k < 16; ++k) {
          if (k < win) {
            const int ti = t - k;
            float a0, a1, a2, a3;
            if (ti >= 0) {
              uint2 u = *reinterpret_cast<const uint2*>(Ub + (size_t)(tt - k) * 1024 + col);
              a0 = bflo(u.x); a1 = bfhi(u.x); a2 = bflo(u.y); a3 = bfhi(u.y);
            } else {
              float4 hh = *reinterpret_cast<const float4*>(sp + (size_t)(15 + ti) * 1024);
              a0 = hh.x; a1 = hh.y; a2 = hh.z; a3 = hh.w;
            }
            if (k == 0) ut = {a0, a1, a2, a3};
            s0 += a0; s1 += a1; s2 += a2; s3 += a3;
          }
        }
        float* po = p.out + O_POOLS + ((size_t)(l * 128 + sb) * 15) * 1024 + col;
        *reinterpret_cast<float4*>(po + (size_t)(11 + t) * 1024) = ut;
        if (t == 0) {
#pragma unroll
          for (int r = 0; r < 11; ++r)
            *reinterpret_cast<float4*>(po + (size_t)r * 1024) = *reinterpret_cast<const float4*>(sp + (size_t)(r + 4) * 1024);
        }
        const float inv = 1.f / (float)win;
        store_bf4(ypre + (size_t)tt * 1024 + col, s0 * inv - ut.x, s1 * inv - ut.y, s2 * inv - ut.z, s3 * inv - ut.w);
      }
    } else {
      const int tb = (bt - 64) * 32;
      const int b = tb >> 11, t0 = tb & 2047;
      float s0 = 0.f, s1 = 0.f, s2 = 0.f, s3 = 0.f;
#pragma unroll
      for (int k = 1; k < 16; ++k) {
        if (k < win && t0 - k >= 0) {
          uint2 u = *reinterpret_cast<const uint2*>(Ub + (size_t)(tb - k) * 1024 + col);
          s0 += bflo(u.x); s1 += bfhi(u.x); s2 += bflo(u.y); s3 += bfhi(u.y);
        }
      }
      for (int c8 = 0; c8 < 32; c8 += 8) {
        uint2 un[8], uo[8];
#pragma unroll
        for (int i = 0; i < 8; ++i) {
          un[i] = *reinterpret_cast<const uint2*>(Ub + (size_t)(tb + c8 + i) * 1024 + col);
          const int told = t0 + c8 + i - win + 1;
          uo[i] = told >= 0 ? *reinterpret_cast<const uint2*>(Ub + (size_t)(tb + c8 + i - win + 1) * 1024 + col) : uint2{0u, 0u};
        }
#pragma unroll
        for (int i = 0; i < 8; ++i) {
          const int t = t0 + c8 + i;
          const float a0 = bflo(un[i].x), a1 = bfhi(un[i].x), a2 = bflo(un[i].y), a3 = bfhi(un[i].y);
          s0 += a0; s1 += a1; s2 += a2; s3 += a3;
          const float inv = frcp_((float)min(t + 1, win));
          store_bf4(ypre + (size_t)(tb + c8 + i) * 1024 + col, s0 * inv - a0, s1 * inv - a1, s2 * inv - a2, s3 * inv - a3);
          if (t >= 2033)
            *reinterpret_cast<float4*>(p.out + O_POOLP + ((size_t)(l * 8 + b) * 15 + (t - 2033)) * 1024 + col) = float4{a0, a1, a2, a3};
          s0 -= bflo(uo[i].x); s1 -= bfhi(uo[i].x); s2 -= bflo(uo[i].y); s3 -= bfhi(uo[i].y);
        }
      }
    }
  }
}

__device__ void scan_task(const Params& p, int l, int seq, int h, int vgb, char* smem, int tid) {
  const int lane = tid & 63, wave = __builtin_amdgcn_readfirstlane(tid >> 6), v = lane & 15, kq = lane >> 4;
  const int vg = vgb + wave;
  const u16* Qa = reinterpret_cast<const u16*>(p.ws + OFF_QA);
  const u16* Ka = reinterpret_cast<const u16*>(p.ws + OFF_KA);
  const u16* Va = reinterpret_cast<const u16*>(p.ws + OFF_VA);
  const float* gbuf = reinterpret_cast<const float*>(p.ws + OFF_G);
  const float* bbuf = reinterpret_cast<const float*>(p.ws + OFF_BETA);
  u16* oraw = reinterpret_cast<u16*>(p.ws + OFF_ORAW);
  const int tok0 = TP + seq * 4;
  const int nT = 4;
  float S[32];
  float* sout;
  {
    const float* s0 = p.state_delta + (((size_t)(l * 128 + seq) * 8 + h) * 128 + kq * 32) * 128 + vg * 16 + v;
#pragma unroll
    for (int i = 0; i < 32; ++i) S[i] = s0[(size_t)i * 128];
    sout = p.out + O_DELTAS + (((size_t)(l * 128 + seq) * 8 + h) * 128 + kq * 32) * 128 + vg * 16 + v;
  }
  uint4 pre0, pre1, pre2, pre3, pre4;
  float pg = 0.f, pbeta = 0.f;
#define SCAN_LD1(J, VAR)                                                                                          \
  {                                                                                                               \
    const int pc = tid + 256 * (J);                                                                               \
    const int tk = pc / 40, w = pc % 40;                                                                          \
    const size_t ro = (size_t)(tok0 + c0_ + (tk < n_ ? tk : 0)) * 1024 + h * 128;                                 \
    const u16* src = w < 16 ? Ka + ro + w * 8 : w < 32 ? Qa + ro + (w - 16) * 8 : Va + ro + vgb * 16 + (w - 32) * 8; \
    VAR = *reinterpret_cast<const uint4*>(src);                                                                   \
  }
#define SCAN_PREFETCH(C0)                                                                                         \
  {                                                                                                               \
    const int c0_ = (C0);                                                                                         \
    const int n_ = min(32, nT - c0_);                                                                             \
    SCAN_LD1(0, pre0) SCAN_LD1(1, pre1) SCAN_LD1(2, pre2) SCAN_LD1(3, pre3) SCAN_LD1(4, pre4)                     \
    if (tid < 32) {                                                                                               \
      const int tk = tid < n_ ? tid : 0;                                                                          \
      pg = gbuf[(size_t)(tok0 + c0_ + tk) * 8 + h];                                                               \
      pbeta = bbuf[(size_t)(tok0 + c0_ + tk) * 8 + h];                                                            \
    }                                                                                                             \
  }
#define SCAN_ST1(J, VAR)                                                                                          \
  {                                                                                                               \
    const int pc = tid + 256 * (J);                                                                               \
    const int tk = pc / 40, w = pc % 40;                                                                          \
    if (tk < n) {                                                                                                 \
      const int dst = tk * 640 + (w < 16 ? w * 16 : w < 32 ? 256 + (w - 16) * 16 : 512 + (w - 32) * 16);          \
      *reinterpret_cast<uint4*>(smem + dst) = VAR;                                                                \
    }                                                                                                             \
  }
  SCAN_PREFETCH(0)
  for (int c0 = 0; c0 < nT; c0 += 32) {
    const int n = min(32, nT - c0);
    __syncthreads();
    SCAN_ST1(0, pre0) SCAN_ST1(1, pre1) SCAN_ST1(2, pre2) SCAN_ST1(3, pre3) SCAN_ST1(4, pre4)
    if (tid < 32) {
      *reinterpret_cast<float*>(smem + 20480 + tid * 4) = pg;
      *reinterpret_cast<float*>(smem + 20480 + 128 + tid * 4) = pbeta;
    }
    __syncthreads();
    if (c0 + 32 < nT) SCAN_PREFETCH(c0 + 32)
    for (int tt = 0; tt < n; ++tt) {
      const char* rowb = smem + tt * 640;
      uint4 kw[4], qw[4];
#pragma unroll
      for (int i = 0; i < 4; ++i) {
        kw[i] = *reinterpret_cast<const uint4*>(rowb + kq * 64 + i * 16);
        qw[i] = *reinterpret_cast<const uint4*>(rowb + 256 + kq * 64 + i * 16);
      }
      const float vv = __uint_as_float((unsigned)(*reinterpret_cast<const u16*>(rowb + 512 + (wave * 16 + v) * 2)) << 16);
      const float gv = *reinterpret_cast<const float*>(smem + 20480 + tt * 4);
      const float be = *reinterpret_cast<const float*>(smem + 20480 + 128 + tt * 4);
      const float a = __expf(gv);
      float kf[32];
#pragma unroll
      for (int i = 0; i < 4; ++i) {
        kf[i * 8 + 0] = bflo(kw[i].x); kf[i * 8 + 1] = bfhi(kw[i].x);
        kf[i * 8 + 2] = bflo(kw[i].y); kf[i * 8 + 3] = bfhi(kw[i].y);
        kf[i * 8 + 4] = bflo(kw[i].z); kf[i * 8 + 5] = bfhi(kw[i].z);
        kf[i * 8 + 6] = bflo(kw[i].w); kf[i * 8 + 7] = bfhi(kw[i].w);
      }
      float r0 = 0.f, r1 = 0.f;
#pragma unroll
      for (int i = 0; i < 32; i += 2) { r0 += kf[i] * S[i]; r1 += kf[i + 1] * S[i + 1]; }
      float r = r0 + r1;
      r += __shfl_xor(r, 16);
      r += __shfl_xor(r, 32);
      const float u = be * (vv - a * r);
#pragma unroll
      for (int i = 0; i < 32; ++i) S[i] = a * S[i] + kf[i] * u;
      float o0 = 0.f, o1 = 0.f;
#pragma unroll
      for (int i = 0; i < 4; ++i) {
        o0 += bflo(qw[i].x) * S[i * 8 + 0]; o1 += bfhi(qw[i].x) * S[i * 8 + 1];
        o0 += bflo(qw[i].y) * S[i * 8 + 2]; o1 += bfhi(qw[i].y) * S[i * 8 + 3];
        o0 += bflo(qw[i].z) * S[i * 8 + 4]; o1 += bfhi(qw[i].z) * S[i * 8 + 5];
        o0 += bflo(qw[i].w) * S[i * 8 + 6]; o1 += bfhi(qw[i].w) * S[i * 8 + 7];
      }
      float o = o0 + o1;
      o += __shfl_xor(o, 16);
      o += __shfl_xor(o, 32);
      if (kq == 0) oraw[(size_t)(tok0 + c0 + tt) * 1024 + h * 128 + vg * 16 + v] = (u16)(pk2(o, o) & 0xffffu);
    }
  }
#pragma unroll
  for (int i = 0; i < 32; ++i) sout[(size_t)i * 128] = S[i];
}

__device__ void pool_gemm_tile(const Params& p, int l, int tl, char* smem, int tid) {
  const int mt = tl >> 3, r = tl & 7, g = r >> 1, nh = r & 1;
  const u16* ypre = reinterpret_cast<const u16*>(p.ws + OFF_Y);
  const u16* W = reinterpret_cast<const u16*>(p.ws + OFF_WPL) + (size_t)(l * 4 + g) * 256 * 256;
  const u16* GP = reinterpret_cast<const u16*>(p.ws + OFF_GP);
  u16* ybin = ybin_row(p.ws, (size_t)mt * 128) - (size_t)mt * 128 * 1024;
  f32x4 acc[4][4];
  acc_zero(acc);
  gemm_dma(ypre + (size_t)mt * 128 * 1024 + g * 256, W + (size_t)nh * 128 * 256, ypre + (size_t)mt * 128 * 1024 + g * 256, W + (size_t)nh * 128 * 256, 1024, 256, 256, true, acc, smem, tid);
  const int c0 = g * 256 + nh * 128;
  const float* psc = p.pool_scale + l * 1024 + c0;
  EPI_LOOP({
    const size_t t = (size_t)mt * 128 + row;
    float4 sc = *reinterpret_cast<const float4*>(psc + col);
    uint2 gp = *reinterpret_cast<const uint2*>(GP + t * 1024 + c0 + col);
    store_bf4(ybin + t * 1024 + c0 + col, v[0] * sc.x * siluf_(bflo(gp.x)), v[1] * sc.y * siluf_(bfhi(gp.x)),
              v[2] * sc.z * siluf_(bflo(gp.y)), v[3] * sc.w * siluf_(bfhi(gp.y)));
  })
}

DI bf16x8 frag_nat(const char* base, int stride, int row0, int kb, int lane) {
  return *reinterpret_cast<const bf16x8*>(base + (row0 + (lane & 15)) * stride + (kb * 32 + (lane >> 4) * 8) * 2);
}
DI bf16x8 frag_perm(const char* base, int stride, int row0, int kb, int lane) {
  const char* pp = base + (row0 + (lane & 15)) * stride + (kb * 32 + (lane >> 4) * 4) * 2;
  uint2 a = *reinterpret_cast<const uint2*>(pp);
  uint2 b = *reinterpret_cast<const uint2*>(pp + 32);
  uint4 u = {a.x, a.y, b.x, b.y};
  return __builtin_bit_cast(bf16x8, u);
}
DI bf16x8 pack_acc(const f32x4& a, const f32x4& b) {
  uint4 u = {pk2(a[0], a[1]), pk2(a[2], a[3]), pk2(b[0], b[1]), pk2(b[2], b[3])};
  return __builtin_bit_cast(bf16x8, u);
}
#define MFMA16(X, Y, C) __builtin_amdgcn_mfma_f32_16x16x32_bf16((X), (Y), (C), 0, 0, 0)
DI uint4 scale8(uint4 u, float s0, float s1, float s2, float s3, float s4, float s5, float s6, float s7) {
  uint4 r;
  r.x = pk2(bflo(u.x) * s0, bfhi(u.x) * s1);
  r.y = pk2(bflo(u.y) * s2, bfhi(u.y) * s3);
  r.z = pk2(bflo(u.z) * s4, bfhi(u.z) * s5);
  r.w = pk2(bflo(u.w) * s6, bfhi(u.w) * s7);
  return r;
}

template <int I, int G>
DI void solve_group(float (&t)[64], float& acc, const float* __restrict__ sA) {
  if constexpr (G * 32 < I) {
    float4 cur[8];
#pragma unroll
    for (int j4 = 0; j4 < 8; ++j4)
      if ((G * 8 + j4) * 4 < I) cur[j4] = *reinterpret_cast<const float4*>(sA + I * 68 + (G * 8 + j4) * 4);
    __builtin_amdgcn_sched_barrier(0);
#pragma unroll
    for (int j4 = 0; j4 < 8; ++j4) {
      constexpr int dummy = 0; (void)dummy;
      const int jb = (G * 8 + j4) * 4;
      if (jb < I) {
        const float4 a = cur[j4];
        if (jb + 0 < I) acc -= a.x * t[jb + 0];
        if (jb + 1 < I) acc -= a.y * t[jb + 1];
        if (jb + 2 < I) acc -= a.z * t[jb + 2];
        if (jb + 3 < I) acc -= a.w * t[jb + 3];
      }
    }
    __builtin_amdgcn_sched_barrier(0);
  }
}
template <int I>
DI void solve_rows(float (&t)[64], const float* __restrict__ sA, int lane) {
  if constexpr (I < 64) {
    float acc = (lane == I) ? 1.f : 0.f;
    solve_group<I, 0>(t, acc, sA);
    solve_group<I, 1>(t, acc, sA);
    t[I] = acc;
    solve_rows<I + 1>(t, sA, lane);
  }
}

__device__ void phase_chunk_prep(const Params& p, int l, char* smem, int tid) {
  const int lane = tid & 63, wave = __builtin_amdgcn_readfirstlane(tid >> 6), r16 = lane & 15, q4 = lane >> 4;
  char* sK = smem;
  char* sQ = smem + 17408;
  char* sKT = smem;
  char* sVT = smem + 18432;
  float* sA = reinterpret_cast<float*>(smem + 36864);
  char* sT = smem + 36864 + 17408;
  float* sG = reinterpret_cast<float*>(smem + 36864 + 17408 + 9216);
  float* sB = sG + 64;
  const u16* Qa = reinterpret_cast<const u16*>(p.ws + OFF_QA);
  const u16* Ka = reinterpret_cast<const u16*>(p.ws + OFF_KA);
  const u16* KT = reinterpret_cast<const u16*>(p.ws + OFF_KT);
  const u16* VT = reinterpret_cast<const u16*>(p.ws + OFF_VA);
  const float* gbuf = reinterpret_cast<const float*>(p.ws + OFF_G);
  const float* bbuf = reinterpret_cast<const float*>(p.ws + OFF_BETA);
  float* GL = reinterpret_cast<float*>(p.ws + OFF_GL);
  for (int cid = blockIdx.x; cid < 2048; cid += gridDim.x) {
    const int bh = cid >> 5, n = cid & 31, b = bh >> 3, h = bh & 7;
    const int tok0 = b * 2048 + n * 64;
    u16* img = reinterpret_cast<u16*>(p.ws + OFF_IMG + (size_t)cid * IMG_BYTES);
    u16* wvt = reinterpret_cast<u16*>(p.ws + OFF_WVT + (size_t)cid * 16384);
    __syncthreads();
    if (tid < 64) {
      float g = gbuf[(size_t)(tok0 + tid) * 8 + h];
#pragma unroll
      for (int o = 1; o < 64; o <<= 1) {
        float t = __shfl_up(g, o);
        if (lane >= o) g += t;
      }
      sG[tid] = g;
      sB[tid] = bbuf[(size_t)(tok0 + tid) * 8 + h];
    }
#pragma unroll
    for (int j = 0; j < 4; ++j) {
      const int pc = tid + 256 * j, row = pc >> 4, c16 = pc & 15;
      *reinterpret_cast<uint4*>(sK + row * 272 + c16 * 16) =
          *reinterpret_cast<const uint4*>(Ka + (size_t)(tok0 + row) * 1024 + h * 128 + c16 * 8);
      *reinterpret_cast<uint4*>(sQ + row * 272 + c16 * 16) =
          *reinterpret_cast<const uint4*>(Qa + (size_t)(tok0 + row) * 1024 + h * 128 + c16 * 8);
    }
    __syncthreads();
    {
      bf16x8 yk[4], yq[4];
#pragma unroll
      for (int kb = 0; kb < 4; ++kb) {
        yk[kb] = frag_nat(sK, 272, wave * 16, kb, lane);
        yq[kb] = frag_nat(sQ, 272, wave * 16, kb, lane);
      }
      const int jy = wave * 16 + r16;
      const float Gy = sG[jy];
#pragma unroll
      for (int it = 0; it < 4; ++it) {
        f32x4 akk = {0.f, 0.f, 0.f, 0.f}, aqk = {0.f, 0.f, 0.f, 0.f};
#pragma unroll
        for (int kb = 0; kb < 4; ++kb) {
          bf16x8 xk = frag_nat(sK, 272, it * 16, kb, lane);
          akk = MFMA16(xk, yk[kb], akk);
          aqk = MFMA16(xk, yq[kb], aqk);
        }
        float wq[4];
#pragma unroll
        for (int e = 0; e < 4; ++e) {
          const int i = it * 16 + q4 * 4 + e;
          const float Gi = sG[i];
          sA[i * 68 + jy] = (i > jy) ? sB[i] * akk[e] * __expf(Gi - Gy) : 0.f;
          wq[e] = (jy >= i) ? aqk[e] * __expf(Gy - Gi) : 0.f;
        }
        store_bf4(img + 16384 + jy * 64 + it * 16 + q4 * 4, wq[0], wq[1], wq[2], wq[3]);
      }
    }
    __syncthreads();
    if (wave == 0) {
      float t[64];
      solve_rows<0>(t, sA, lane);
#pragma unroll
      for (int i = 0; i < 64; ++i) *reinterpret_cast<u16*>(sT + i * 144 + lane * 2) = (u16)(pk2(t[i], t[i]) & 0xffffu);
    } else {
      const float Glast = sG[63];
      if (tid == 64) GL[cid] = __expf(Glast);
#pragma unroll 1
      for (int pc = tid - 64; pc < 1024; pc += 192) {
        const int c = pc >> 3, i8 = pc & 7;
        uint4 uk = *reinterpret_cast<const uint4*>(KT + ((size_t)bh * 128 + c) * 2048 + n * 64 + i8 * 8);
        uint4 uv = *reinterpret_cast<const uint4*>(VT + ((size_t)bh * 128 + c) * 2048 + n * 64 + i8 * 8);
        const float* gp = sG + i8 * 8;
        const float* bp = sB + i8 * 8;
        *reinterpret_cast<uint4*>(sKT + c * 144 + i8 * 16) =
            scale8(uk, bp[0] * __expf(gp[0]), bp[1] * __expf(gp[1]), bp[2] * __expf(gp[2]), bp[3] * __expf(gp[3]),
                   bp[4] * __expf(gp[4]), bp[5] * __expf(gp[5]), bp[6] * __expf(gp[6]), bp[7] * __expf(gp[7]));
        *reinterpret_cast<uint4*>(sVT + c * 144 + i8 * 16) = scale8(uv, bp[0], bp[1], bp[2], bp[3], bp[4], bp[5], bp[6], bp[7]);
        *reinterpret_cast<uint4*>(img + 20480 + c * 64 + i8 * 8) =
            scale8(uk, __expf(Glast - gp[0]), __expf(Glast - gp[1]), __expf(Glast - gp[2]), __expf(Glast - gp[3]),
                   __expf(Glast - gp[4]), __expf(Glast - gp[5]), __expf(Glast - gp[6]), __expf(Glast - gp[7]));
      }
#pragma unroll 1
      for (int pc = tid - 64; pc < 1024; pc += 192) {
        const int i = pc >> 4, c16 = pc & 15;
        uint4 u = *reinterpret_cast<const uint4*>(Qa + (size_t)(tok0 + i) * 1024 + h * 128 + c16 * 8);
        const float sc = __expf(sG[i]);
        *reinterpret_cast<uint4*>(img + 8192 + i * 128 + c16 * 8) = scale8(u, sc, sc, sc, sc, sc, sc, sc, sc);
      }
    }
    __syncthreads();
    {
      bf16x8 yt[2];
#pragma unroll
      for (int kb = 0; kb < 2; ++kb) yt[kb] = frag_nat(sT, 144, wave * 16, kb, lane);
      const int iy = wave * 16 + r16;
#pragma unroll
      for (int ct = 0; ct < 8; ++ct) {
        f32x4 a = {0.f, 0.f, 0.f, 0.f};
#pragma unroll
        for (int kb = 0; kb < 2; ++kb) a = MFMA16(frag_nat(sKT, 144, ct * 16, kb, lane), yt[kb], a);
        store_bf4(img + iy * 128 + ct * 16 + q4 * 4, -a[0], -a[1], -a[2], -a[3]);
      }
#pragma unroll
      for (int v2 = 0; v2 < 2; ++v2) {
        const int vt = wave * 2 + v2;
        bf16x8 yv[2];
#pragma unroll
        for (int kb = 0; kb < 2; ++kb) yv[kb] = frag_nat(sVT, 144, vt * 16, kb, lane);
#pragma unroll
        for (int it = 0; it < 4; ++it) {
          f32x4 a = {0.f, 0.f, 0.f, 0.f};
#pragma unroll
          for (int kb = 0; kb < 2; ++kb) a = MFMA16(frag_nat(sT, 144, it * 16, kb, lane), yv[kb], a);
          store_bf4(wvt + (vt * 16 + r16) * 64 + it * 16 + q4 * 4, a[0], a[1], a[2], a[3]);
        }
      }
    }
  }
}

#define PRE_LIST(X) X(0) X(1) X(2) X(3) X(4) X(5) X(6) X(7) X(8) X(9) X(10) X(11) X(12) X(13)
__device__ void chunk_scan_task(const Params& p, int l, int bh, int vhalf, char* smem, int tid) {
  const int lane = tid & 63, wave = __builtin_amdgcn_readfirstlane(tid >> 6), r16 = lane & 15, q4 = lane >> 4;
  const int b = bh >> 3, h = bh & 7;
  const int v0 = vhalf * 64 + wave * 16;
  const char* img0 = p.ws + OFF_IMG + (size_t)(bh * 32) * IMG_BYTES;
  const u16* wvt0 = reinterpret_cast<const u16*>(p.ws + OFF_WVT + (size_t)(bh * 32) * 16384);
  const float* GL = reinterpret_cast<const float*>(p.ws + OFF_GL) + bh * 32;
  u16* oraw = reinterpret_cast<u16*>(p.ws + OFF_ORAW);
  char* sWk = smem;
  char* sQd = smem + 17408;
  char* sQK = smem + 34816;
  char* sKtT = smem + 44032;
  f32x4 S[8];
#pragma unroll
  for (int i = 0; i < 8; ++i) S[i] = f32x4{0.f, 0.f, 0.f, 0.f};
#define PRE_DECL(J) uint4 pre##J;
  PRE_LIST(PRE_DECL)
  uint2 wv0, wv1, wv2, wv3;
  float gln;
#define PRE_LOAD(J) pre##J = *reinterpret_cast<const uint4*>(imgn + J * 4096 + voff);
#define SCAN_FETCH(N)                                                                                   \
  {                                                                                                     \
    const char* imgn = img0 + (size_t)(N) * IMG_BYTES;                                                  \
    PRE_LIST(PRE_LOAD)                                                                                  \
    const u16* wp = wvt0 + (size_t)(N) * 8192 + wvoff;                                                  \
    wv0 = *reinterpret_cast<const uint2*>(wp);                                                          \
    wv1 = *reinterpret_cast<const uint2*>(wp + 16);                                                     \
    wv2 = *reinterpret_cast<const uint2*>(wp + 32);                                                     \
    wv3 = *reinterpret_cast<const uint2*>(wp + 48);                                                     \
    gln = GL[N];                                                                                        \
  }
#define PRE_STORE(J)                                                                                    \
  {                                                                                                     \
    const int pc = tid + 256 * J;                                                                       \
    int off;                                                                                            \
    if (J < 4) off = (pc >> 4) * 272 + (pc & 15) * 16;                                                  \
    else if (J < 8) off = 17408 + ((pc - 1024) >> 4) * 272 + (pc & 15) * 16;                            \
    else if (J < 10) off = 34816 + ((pc - 2048) >> 3) * 144 + (pc & 7) * 16;                            \
    else off = 44032 + ((pc - 2560) >> 3) * 144 + (pc & 7) * 16;                                        \
    *reinterpret_cast<uint4*>(smem + off) = pre##J;                                                     \
  }
  const unsigned voff = (unsigned)tid * 16u;
  const unsigned wvoff = (unsigned)((v0 + r16) * 64 + q4 * 4);
  SCAN_FETCH(0)
  for (int n = 0; n < 32; ++n) {
    __syncthreads();
    PRE_LIST(PRE_STORE)
    __syncthreads();
    const uint2 c0 = wv0, c1 = wv1, c2 = wv2, c3 = wv3;
    const float gl = gln;
    if (n + 1 < 32) SCAN_FETCH(n + 1)
    bf16x8 Sop[4];
#pragma unroll
    for (int kb = 0; kb < 4; ++kb) Sop[kb] = pack_acc(S[2 * kb], S[2 * kb + 1]);
    f32x4 U[4];
    U[0] = f32x4{bflo(c0.x), bfhi(c0.x), bflo(c0.y), bfhi(c0.y)};
    U[1] = f32x4{bflo(c1.x), bfhi(c1.x), bflo(c1.y), bfhi(c1.y)};
    U[2] = f32x4{bflo(c2.x), bfhi(c2.x), bflo(c2.y), bfhi(c2.y)};
    U[3] = f32x4{bflo(c3.x), bfhi(c3.x), bflo(c3.y), bfhi(c3.y)};
#pragma unroll
    for (int it = 0; it < 4; ++it) {
#pragma unroll
      for (int kb = 0; kb < 4; ++kb) U[it] = MFMA16(frag_perm(sWk, 272, it * 16, kb, lane), Sop[kb], U[it]);
    }
    bf16x8 Uop[2];
    Uop[0] = pack_acc(U[0], U[1]);
    Uop[1] = pack_acc(U[2], U[3]);
    const size_t tokb = (size_t)b * 2048 + n * 64;
    const unsigned olane = (unsigned)(q4 * 4 * 1024 + v0 + r16);
#pragma unroll
    for (int it = 0; it < 4; ++it) {
      f32x4 O = {0.f, 0.f, 0.f, 0.f};
#pragma unroll
      for (int kb = 0; kb < 4; ++kb) O = MFMA16(frag_perm(sQd, 272, it * 16, kb, lane), Sop[kb], O);
#pragma unroll
      for (int jb = 0; jb < 2; ++jb) O = MFMA16(frag_perm(sQK, 144, it * 16, jb, lane), Uop[jb], O);
#pragma unroll
      for (int e = 0; e < 4; ++e) {
        u16* pst = oraw + (tokb + it * 16 + e) * 1024 + h * 128;
        pst[olane] = (u16)(pk2(O[e], O[e]) & 0xffffu);
      }
    }
#pragma unroll
    for (int kt = 0; kt < 8; ++kt) {
      f32x4 a = S[kt];
      a[0] *= gl; a[1] *= gl; a[2] *= gl; a[3] *= gl;
#pragma unroll
      for (int jb = 0; jb < 2; ++jb) a = MFMA16(frag_perm(sKtT, 144, kt * 16, jb, lane), Uop[jb], a);
      S[kt] = a;
    }
  }
  float* sout = p.out + O_DELTAP + ((size_t)(l * 8 + b) * 8 + h) * 128 * 128 + v0 + r16;
#pragma unroll
  for (int kt = 0; kt < 8; ++kt)
#pragma unroll
    for (int e = 0; e < 4; ++e) sout[(size_t)(kt * 16 + q4 * 4 + e) * 128] = S[kt][e];
}

__device__ void pp_gemm_tile(const Params& p, int l, int tl, char* smem, int tid) {
  const int mt = tl >> 3, nt = tl & 7;
  const u16* pb = reinterpret_cast<const u16*>(p.ws + OFF_PB);
  const u16* Wp = reinterpret_cast<const u16*>(p.ws + OFF_WP) + (size_t)l * 1024 * 256;
  u16* pp = pp_row(p.ws, (size_t)mt * 128) - (size_t)mt * 128 * 1024;
  f32x4 acc[4][4];
  acc_zero(acc);
  gemm_dma(pb + (size_t)mt * 128 * 256, Wp + (size_t)nt * 128 * 256, pb + (size_t)mt * 128 * 256, Wp + (size_t)nt * 128 * 256, 256, 256, 256, true, acc, smem, tid);
  EPI_LOOP({
    const size_t t = (size_t)mt * 128 + row;
    store_bf4(pp + t * 1024 + nt * 128 + col, v[0], v[1], v[2], v[3]);
  })
}

__device__ void phase_scan(const Params& p, int l, char* smem, int tid, int cidx = 0) {
  unsigned* cnt = reinterpret_cast<unsigned*>(p.ws + OFF_CNT) + l + cidx;
  int* s_item = reinterpret_cast<int*>(smem + 65024);
  const int n_items = 128 + 2048 + 1056 + 1056;
  while (true) {
    __syncthreads();
    if (tid == 0) *s_item = (int)atomicAdd(cnt, 1u);
    __syncthreads();
    int it = *s_item;
    if (it >= n_items) break;
    it = __builtin_amdgcn_readfirstlane(it);
    int tq = tid;
    asm volatile("" : "+v"(tq));
    if (it < 128) {
      chunk_scan_task(p, l, it >> 1, it & 1, smem, tq);
    } else if (it < 128 + 2048) {
      const int wt = (it - 128) * 4;
      scan_task(p, l, wt >> 6, (wt >> 3) & 7, wt & 7, smem, tq);
    } else if (it < 128 + 2048 + 1056) {
      pool_gemm_tile(p, l, it - 2176, smem, tq);
    } else {
      pp_gemm_tile(p, l, it - 3232, smem, tq);
    }
  }
}

__device__ void phase_onorm(const Params& p, int l, int tid) {
  const int lane = tid & 63, wave = __builtin_amdgcn_readfirstlane(tid >> 6);
  const u16* oraw = reinterpret_cast<const u16*>(p.ws + OFF_ORAW);
  const u16* Zb = reinterpret_cast<const u16*>(p.ws + OFF_Z);
  u16* og = reinterpret_cast<u16*>(p.ws + OFF_OG);
  float gn[16];
#pragma unroll
  for (int i = 0; i < 4; ++i) {
    float4 w = *reinterpret_cast<const float4*>(p.gdn_norm + l * 128 + (lane & 7) * 16 + i * 4);
    gn[i * 4] = w.x; gn[i * 4 + 1] = w.y; gn[i * 4 + 2] = w.z; gn[i * 4 + 3] = w.w;
  }
  for (int r = blockIdx.x * 4 + wave; r < T; r += gridDim.x * 4) {
    uint4 o0 = *reinterpret_cast<const uint4*>(oraw + (size_t)r * 1024 + lane * 16);
    uint4 o1 = *reinterpret_cast<const uint4*>(oraw + (size_t)r * 1024 + lane * 16 + 8);
    uint4 z0 = *reinterpret_cast<const uint4*>(Zb + (size_t)r * 1024 + lane * 16);
    uint4 z1 = *reinterpret_cast<const uint4*>(Zb + (size_t)r * 1024 + lane * 16 + 8);
    float o[16], z[16];
    o[0] = bflo(o0.x); o[1] = bfhi(o0.x); o[2] = bflo(o0.y); o[3] = bfhi(o0.y);
    o[4] = bflo(o0.z); o[5] = bfhi(o0.z); o[6] = bflo(o0.w); o[7] = bfhi(o0.w);
    o[8] = bflo(o1.x); o[9] = bfhi(o1.x); o[10] = bflo(o1.y); o[11] = bfhi(o1.y);
    o[12] = bflo(o1.z); o[13] = bfhi(o1.z); o[14] = bflo(o1.w); o[15] = bfhi(o1.w);
    z[0] = bflo(z0.x); z[1] = bfhi(z0.x); z[2] = bflo(z0.y); z[3] = bfhi(z0.y);
    z[4] = bflo(z0.z); z[5] = bfhi(z0.z); z[6] = bflo(z0.w); z[7] = bfhi(z0.w);
    z[8] = bflo(z1.x); z[9] = bfhi(z1.x); z[10] = bflo(z1.y); z[11] = bfhi(z1.y);
    z[12] = bflo(z1.z); z[13] = bfhi(z1.z); z[14] = bflo(z1.w); z[15] = bfhi(z1.w);
    float ss = 0.f;
#pragma unroll
    for (int i = 0; i < 16; ++i) ss += o[i] * o[i];
    ss += __shfl_xor(ss, 1);
    ss += __shfl_xor(ss, 2);
    ss += __shfl_xor(ss, 4);
    const float rstd = rsqrtf(ss * (1.f / 128.f) + EPS);
    float y[16];
#pragma unroll
    for (int i = 0; i < 16; ++i) y[i] = o[i] * rstd * gn[i] * siluf_(z[i]);
    uint4 w0, w1;
    w0.x = pk2(y[0], y[1]); w0.y = pk2(y[2], y[3]); w0.z = pk2(y[4], y[5]); w0.w = pk2(y[6], y[7]);
    w1.x = pk2(y[8], y[9]); w1.y = pk2(y[10], y[11]); w1.z = pk2(y[12], y[13]); w1.w = pk2(y[14], y[15]);
    *reinterpret_cast<uint4*>(og + (size_t)r * 1024 + lane * 16) = w0;
    *reinterpret_cast<uint4*>(og + (size_t)r * 1024 + lane * 16 + 8) = w1;
  }
}

__device__ void phase_merge(const Params& p, int l, char* smem, int tid) {
  const u16* og = reinterpret_cast<const u16*>(p.ws + OFF_OG);
  const u16* Wa = reinterpret_cast<const u16*>(p.ws + OFF_WA) + (size_t)l * 1024 * 1024;
  const u16* Wb = reinterpret_cast<const u16*>(p.ws + OFF_WB) + (size_t)l * 1024 * 1024;
  const u16* GA = reinterpret_cast<const u16*>(p.ws + OFF_GA);
  const u16* GB = reinterpret_cast<const u16*>(p.ws + OFF_GB);
  u16* mbuf = reinterpret_cast<u16*>(p.ws + OFF_M);
  XCD_TILE_LOOP(mt, nt) {
    f32x4 acc[4][4];
    acc_zero(acc);
    gemm_dma(og + (size_t)mt * 128 * 1024, Wa + (size_t)nt * 128 * 1024, og + (size_t)mt * 128 * 1024, Wa + (size_t)nt * 128 * 1024, 1024, 1024, 1024, true, acc, smem, tid);
    EPI_LOOP({
      const size_t t = (size_t)mt * 128 + row;
      uint2 ga = *reinterpret_cast<const uint2*>(GA + t * 1024 + nt * 128 + col);
      uint2 gb = *reinterpret_cast<const uint2*>(GB + t * 1024 + nt * 128 + col);
      v[0] *= (1.f + __expf(-bflo(gb.x))) * frcp_(1.f + __expf(-bflo(ga.x)));
      v[1] *= (1.f + __expf(-bfhi(gb.x))) * frcp_(1.f + __expf(-bfhi(ga.x)));
      v[2] *= (1.f + __expf(-bflo(gb.y))) * frcp_(1.f + __expf(-bflo(ga.y)));
      v[3] *= (1.f + __expf(-bfhi(gb.y))) * frcp_(1.f + __expf(-bfhi(ga.y)));
    })
    gemm_dma(ybin_row(p.ws, (size_t)mt * 128), Wb + (size_t)nt * 128 * 1024, ybin_row(p.ws, (size_t)mt * 128), Wb + (size_t)nt * 128 * 1024, 1024, 1024, 1024, true, acc, smem, tid);
    EPI_LOOP({
      const size_t t = (size_t)mt * 128 + row;
      uint2 gb = *reinterpret_cast<const uint2*>(GB + t * 1024 + nt * 128 + col);
      store_bf4(mbuf + t * 1024 + nt * 128 + col, v[0] * sigmoidf_(bflo(gb.x)), v[1] * sigmoidf_(bfhi(gb.x)),
                v[2] * sigmoidf_(bflo(gb.y)), v[3] * sigmoidf_(bfhi(gb.y)));
    })
  }
}

__device__ void phase_out(const Params& p, int l, char* smem, int tid) {
  const u16* mbuf = reinterpret_cast<const u16*>(p.ws + OFF_M);
  const u16* Wo = reinterpret_cast<const u16*>(p.ws + OFF_WO) + (size_t)l * 1024 * 1024;
  u16* x1b = reinterpret_cast<u16*>(p.ws + OFF_Y);
  float* ssq = reinterpret_cast<float*>(p.ws + OFF_SSQ);
  GREGS_DECL;
  bool first = true;
  XCD_TILE_LOOP_N(mt, nt, mtn, ntn) {
    f32x4 acc[4][4];
    acc_zero(acc);
    {
      gemm_dma(mbuf + (size_t)mt * 128 * 1024, Wo + (size_t)nt * 128 * 1024, mbuf + (size_t)mtn * 128 * 1024,
                  Wo + (size_t)ntn * 128 * 1024, 1024, 1024, 1024, first, acc, smem, tid);
      first = false;
      const int lane_ = tid & 63, wave_ = __builtin_amdgcn_readfirstlane(tid >> 6), wm_ = wave_ >> 1, wn_ = wave_ & 1;
#pragma unroll
      for (int m = 0; m < 4; ++m) {
        const int row = wm_ * 64 + m * 16 + (lane_ & 15);
        const size_t t = (size_t)mt * 128 + row;
        const float* xin = (l == 0) ? (t < TP ? p.x_prompt + t * 1024 : p.x_sample + (t - TP) * 1024) : p.out + t * 1024;
        float ss = 0.f;
#pragma unroll
        for (int n = 0; n < 4; ++n) {
          const int col = nt * 128 + wn_ * 64 + n * 16 + (lane_ >> 4) * 4;
          float4 xi = *reinterpret_cast<const float4*>(xin + col);
          float4 o;
          o.x = xi.x + acc[m][n][0]; o.y = xi.y + acc[m][n][1]; o.z = xi.z + acc[m][n][2]; o.w = xi.w + acc[m][n][3];
          *reinterpret_cast<float4*>(p.out + t * 1024 + col) = o;
          store_bf4(x1b + t * 1024 + col, o.x, o.y, o.z, o.w);
          ss += o.x * o.x + o.y * o.y + o.z * o.z + o.w * o.w;
        }
        ss += __shfl_xor(ss, 16);
        ss += __shfl_xor(ss, 32);
        if ((lane_ >> 4) == 0) ssq[t * 16 + nt * 2 + wn_] = ss;
      }
    }
  }
}

__device__ void phase_gate(const Params& p, int l, char* smem, int tid) {
  const u16* x1b = reinterpret_cast<const u16*>(p.ws + OFF_Y);
  const u16* Wg = reinterpret_cast<const u16*>(p.ws + OFF_WG) + (size_t)l * 1024 * 1024;
  const float* ssq = reinterpret_cast<const float*>(p.ws + OFF_SSQ);
  GREGS_DECL;
  bool first = true;
  XCD_TILE_LOOP_N(mt, nt, mtn, ntn) {
    f32x4 acc[4][4];
    acc_zero(acc);
    gemm_dma(x1b + (size_t)mt * 128 * 1024, Wg + (size_t)nt * 128 * 1024, x1b + (size_t)mtn * 128 * 1024,
                Wg + (size_t)ntn * 128 * 1024, 1024, 1024, 1024, first, acc, smem, tid);
    first = false;
    const int lane_ = tid & 63, wave_ = __builtin_amdgcn_readfirstlane(tid >> 6), wm_ = wave_ >> 1, wn_ = wave_ & 1;
#pragma unroll
    for (int m = 0; m < 4; ++m) {
      const int row = wm_ * 64 + m * 16 + (lane_ & 15);
      const size_t t = (size_t)mt * 128 + row;
      float ss = 0.f;
#pragma unroll
      for (int i = 0; i < 4; ++i) {
        float4 s4 = *reinterpret_cast<const float4*>(ssq + t * 16 + i * 4);
        ss += s4.x + s4.y + s4.z + s4.w;
      }
      const float rstd = rsqrtf(ss * (1.f / 1024.f) + EPS);
#pragma unroll
      for (int n = 0; n < 4; ++n) {
        const int col = nt * 128 + wn_ * 64 + n * 16 + (lane_ >> 4) * 4;
        float4 xi = *reinterpret_cast<const float4*>(p.out + t * 1024 + col);
        uint2 pv = *reinterpret_cast<const uint2*>(pp_row(p.ws, t) + col);
        float4 o;
        o.x = xi.x + sigmoidf_(rstd * acc[m][n][0]) * bflo(pv.x);
        o.y = xi.y + sigmoidf_(rstd * acc[m][n][1]) * bfhi(pv.x);
        o.z = xi.z + sigmoidf_(rstd * acc[m][n][2]) * bflo(pv.y);
        o.w = xi.w + sigmoidf_(rstd * acc[m][n][3]) * bfhi(pv.y);
        *reinterpret_cast<float4*>(p.out + t * 1024 + col) = o;
      }
    }
  }
}

__global__ void __launch_bounds__(NT, 2) fwd_megakernel(Params p) {
  __shared__ __attribute__((aligned(16))) char smem[65536];
  cg::grid_group grid = cg::this_grid();
  __shared__ uint4 xb_words;
  if (threadIdx.x == 0) xb_words = make_uint4(0u, 0u, 0u, 0u);
  __syncthreads();
  XcdBarrier xb = xcd_barrier_post(reinterpret_cast<unsigned*>(p.ws + OFF_BAR), (volatile LAS unsigned*)&xb_words);
  if (p.ph_hi > 1000) grid.sync();
  for (int ph = p.ph_lo; ph < p.ph_hi; ++ph) {
    if (ph > p.ph_lo) xcd_barrier(xb);
    int tid = threadIdx.x;
    asm volatile("" : "+v"(tid));
    if (ph == 18) { phase_final(p, tid); continue; }
    const int l = ph / 9, kind = ph % 9;
    switch (kind) {
      case 0:
        if (l == 0) {
          phase_convert_weights(p, smem, tid);
        }
        phase_prep(p, l, smem, tid);
        break;
      case 1: phase_inproj(p, l, smem, tid); if (REPEAT_KIND == 1) phase_inproj(p, l, smem, tid); break;
      case 2: phase_conv_pool(p, l, smem, tid); if (REPEAT_KIND == 20) phase_conv_pool(p, l, smem, tid, 1); if (REPEAT_KIND == 21) phase_conv_pool(p, l, smem, tid, 2); break;
      case 3: phase_chunk_prep(p, l, smem, tid); if (REPEAT_KIND == 3) phase_chunk_prep(p, l, smem, tid); break;
      case 4: phase_scan(p, l, smem, tid); if (REPEAT_KIND == 4) phase_scan(p, l, smem, tid, 2); break;
      case 5:
        phase_onorm(p, l, tid);
        break;
      case 6: phase_merge(p, l, smem, tid); if (REPEAT_KIND == 6) phase_merge(p, l, smem, tid); break;
      case 7: phase_out(p, l, smem, tid); break;
      case 8: phase_gate(p, l, smem, tid); break;
    }
  }
}

extern "C" void kernel_launch(void* const* d_in, const int* in_sizes, int n_in, void* d_out, int out_size, void* d_ws,
                              size_t ws_size, hipStream_t stream) {
  static int grid_blocks = 0;
  if (!grid_blocks) {
    int dev = 0, cus = 0, per_cu = 0;
    hipGetDevice(&dev);
    hipDeviceGetAttribute(&cus, hipDeviceAttributeMultiprocessorCount, dev);
    hipOccupancyMaxActiveBlocksPerMultiprocessor(&per_cu, fwd_megakernel, NT, 0);
    if (per_cu > 2) per_cu = 2;
    if (per_cu < 1) per_cu = 1;
    grid_blocks = cus * per_cu;
  }
  Params p{};
  const float** pp = reinterpret_cast<const float**>(&p);
  for (int i = 0; i < 22; ++i) pp[i] = reinterpret_cast<const float*>(d_in[i]);
  p.out = reinterpret_cast<float*>(d_out);
  p.ws = reinterpret_cast<char*>(d_ws);
  if (ws_size < WS_TOTAL) { fprintf(stderr, "workspace too small: %zu < %zu\n", ws_size, (size_t)WS_TOTAL); return; }
  hipMemsetAsync(p.ws + OFF_BAR, 0, ZERO_BYTES, stream);
#if ONE_LAUNCH
  p.ph_lo = 0; p.ph_hi = 19;
  void* args[] = {&p};
  hipError_t e = hipLaunchCooperativeKernel((void*)fwd_megakernel, dim3(grid_blocks), dim3(NT), args, 0, stream);
  if (e != hipSuccess) fprintf(stderr, "cooperative launch failed: %s (grid %d)\n", hipGetErrorString(e), grid_blocks);
#else
  for (int ph = 0; ph < 19; ++ph) {
    p.ph_lo = ph; p.ph_hi = ph + 1;
    fwd_megakernel<<<dim3(grid_blocks), dim3(NT), 0, stream>>>(p);
  }
#endif
}
```

```cpp
#include <hip/hip_runtime.h>
#include <hip/hip_cooperative_groups.h>
#include <cstdio>
namespace cg = cooperative_groups;

typedef unsigned short u16;
using bf16x8 = __attribute__((ext_vector_type(8))) short;
using f32x4 = __attribute__((ext_vector_type(4))) float;
typedef __bf16 bf16x2_t __attribute__((ext_vector_type(2)));
typedef float f32x2_t __attribute__((ext_vector_type(2)));
#define DI __device__ __forceinline__

#ifndef REPEAT_KIND
#define REPEAT_KIND -1
#endif
#ifndef ONE_LAUNCH
#define ONE_LAUNCH 1
#endif

constexpr int NT = 256;
constexpr int TP = 16384, TS = 512, T = TP + TS;
constexpr int D = 1024, INW = 8208;
constexpr float EPS = 1e-6f;

constexpr size_t SLOT = (size_t)T * 1024 * 2;
constexpr size_t OFF_WIN = 0;
constexpr size_t OFF_WA = OFF_WIN + (size_t)2 * 8192 * 1024 * 2;
constexpr size_t OFF_WB = OFF_WA + (size_t)2 * 1024 * 1024 * 2;
constexpr size_t OFF_WO = OFF_WB + (size_t)2 * 1024 * 1024 * 2;
constexpr size_t OFF_WG = OFF_WO + (size_t)2 * 1024 * 1024 * 2;
constexpr size_t OFF_WP = OFF_WG + (size_t)2 * 1024 * 1024 * 2;
constexpr size_t OFF_WPL = OFF_WP + (size_t)2 * 1024 * 256 * 2;
constexpr size_t OFF_PB = OFF_WPL + (size_t)2 * 4 * 256 * 256 * 2;
constexpr size_t OFF_G = OFF_PB + (size_t)T * 256 * 2;
constexpr size_t OFF_BETA = OFF_G + (size_t)T * 8 * 4;
constexpr size_t OFF_SSQ = OFF_BETA + (size_t)T * 8 * 4;
constexpr size_t OFF_BAR = OFF_SSQ + (size_t)T * 16 * 4;
constexpr size_t OFF_CNT = OFF_BAR + 14336;
constexpr size_t ZERO_BYTES = 14336 + 256;
constexpr size_t OFF_GL = OFF_CNT + 256;
constexpr size_t OFF_P1 = OFF_GL + 2048 * 4;
constexpr size_t OFF_U = OFF_P1 + 3 * SLOT;
constexpr size_t OFF_EXT = OFF_U + SLOT;
constexpr size_t IMG_BYTES = 57344;
constexpr size_t OFF_IMG = OFF_P1;
constexpr size_t OFF_WVT = OFF_IMG + 2048 * IMG_BYTES;
constexpr size_t OFF_H = OFF_EXT + (2048 * IMG_BYTES + 2048 * 16384 - 4 * SLOT) + 256;
constexpr size_t OFF_Z = OFF_H + SLOT;
constexpr size_t OFF_GP = OFF_Z + SLOT;
constexpr size_t OFF_GA = OFF_GP + SLOT;
constexpr size_t OFF_GB = OFF_GA + SLOT;
constexpr size_t OFF_QA = OFF_GB + SLOT;
constexpr size_t OFF_KA = OFF_QA + SLOT;
constexpr size_t OFF_VA = OFF_KA + SLOT;
constexpr size_t OFF_Y = OFF_VA + SLOT;
constexpr size_t WS_TOTAL = OFF_Y + SLOT;
constexpr size_t OFF_OG = OFF_P1, OFF_M = OFF_P1 + 2 * SLOT, OFF_ORAW = OFF_H, OFF_KT = OFF_H;
constexpr size_t OFF_YB_P = OFF_QA, OFF_YB_S = OFF_VA, OFF_PP_P = OFF_KA, OFF_PP_S = OFF_VA + (size_t)TS * 1024 * 2;

constexpr size_t O_Y = 0;
constexpr size_t O_CONVP = (size_t)T * 1024;
constexpr size_t O_DELTAP = O_CONVP + (size_t)2 * 8 * 3 * 3072;
constexpr size_t O_POOLP = O_DELTAP + (size_t)2 * 8 * 8 * 128 * 128;
constexpr size_t O_CONVS = O_POOLP + (size_t)2 * 8 * 15 * 1024;
constexpr size_t O_DELTAS = O_CONVS + (size_t)2 * 128 * 3 * 3072;
constexpr size_t O_POOLS = O_DELTAS + (size_t)2 * 128 * 8 * 128 * 128;

DI u16* ybin_row(char* ws, size_t t) { return reinterpret_cast<u16*>(ws + (t < (size_t)TP ? OFF_YB_P + t * 2048 : OFF_YB_S + (t - TP) * 2048)); }
DI u16* pp_row(char* ws, size_t t) { return reinterpret_cast<u16*>(ws + (t < (size_t)TP ? OFF_PP_P + t * 2048 : OFF_PP_S + (t - TP) * 2048)); }
struct Params {
  const float *x_prompt, *x_sample, *p_prompt, *p_sample, *state_conv, *state_delta, *state_pool, *norm_mix, *w_in,
      *conv_w, *a_log, *dt_bias, *gdn_norm, *w_proj_a, *pool_w, *pool_scale, *w_proj_b, *w_out, *norm_ple, *w_ple_gate,
      *w_ple_proj, *final_norm;
  float* out;
  char* ws;
  int ph_lo, ph_hi;
};

DI unsigned pk2(float a, float b) {
  f32x2_t v = {a, b};
  bf16x2_t r = __builtin_convertvector(v, bf16x2_t);
  return __builtin_bit_cast(unsigned, r);
}
DI float bflo(unsigned u) { return __uint_as_float(u << 16); }
DI float bfhi(unsigned u) { return __uint_as_float(u & 0xffff0000u); }
DI float frcp_(float x) { return __builtin_amdgcn_rcpf(x); }
DI float sigmoidf_(float x) { return frcp_(1.f + __expf(-x)); }
DI float siluf_(float x) { return x * frcp_(1.f + __expf(-x)); }
DI float wave_sum(float v) {
#pragma unroll
  for (int o = 32; o >= 1; o >>= 1) v += __shfl_xor(v, o);
  return v;
}

DI int lds_off(int r, int c) {
  int st = (r >> 4) * 2 + (c >> 5), rr = r & 15, cc = c & 31, ob = rr * 64 + cc * 2;
  return st * 1024 + (ob ^ (((ob >> 9) & 1) << 5));
}

#define XB_TMO      128
#define XB_XCNT(j)  (256  + 64 * (j))
#define XB_XSUB(j)  (1280 + 64 * (j))
#define XB_XGEN(j)  (2304 + 64 * (j))
#define XB_TOP      3328
#define XB_TOPGEN   3392
#define XB_SPIN_CAP (1u << 20)
#define LAS __attribute__((address_space(3)))
DI unsigned xb_ld(unsigned* p) { return __hip_atomic_load(p, __ATOMIC_RELAXED, __HIP_MEMORY_SCOPE_AGENT); }
DI unsigned xb_add(unsigned* p, unsigned v) { return __hip_atomic_fetch_add(p, v, __ATOMIC_RELAXED, __HIP_MEMORY_SCOPE_AGENT); }
DI unsigned xb_xcc_id() { return (unsigned)__builtin_amdgcn_s_getreg((3 << 11) | 20) & 0xFu; }
#define XB_SPIN(cond, bar) do { unsigned _sp = 0; while (cond) { __builtin_amdgcn_s_sleep(1); \
    if ((++_sp & 255u) == 0u) { if (xb_ld(&(bar)[XB_TMO])) break; if (_sp > XB_SPIN_CAP) { atomicAdd(&(bar)[XB_TMO], 1u); break; } } } } while (0)
struct XcdBarrier { unsigned* bar; unsigned x; volatile LAS unsigned* st; };
DI XcdBarrier xcd_barrier_post(unsigned* bar, volatile LAS unsigned* st) {
  XcdBarrier b; b.bar = bar; b.x = xb_xcc_id(); b.st = st;
  if (threadIdx.x == 0) (void)xb_add(&bar[XB_XCNT(b.x)], 1u);
  return b;
}
DI void xcd_barrier_complete(unsigned* bar, unsigned x, unsigned& nloc, unsigned& nx) {
  const unsigned G = gridDim.x * gridDim.y * gridDim.z;
  unsigned sum, cnt, mine, sp = 0u;
  for (;;) {
    sum = 0u; cnt = 0u; mine = 0u;
#pragma unroll
    for (unsigned j = 0; j < 16; ++j) { const unsigned c = xb_ld(&bar[XB_XCNT(j)]); sum += c; cnt += (c > 0u) ? 1u : 0u; mine = (j == x) ? c : mine; }
    if (sum == G) break;
    __builtin_amdgcn_s_sleep(1);
    if ((++sp & 255u) == 0u) { if (xb_ld(&bar[XB_TMO])) break; if (sp > XB_SPIN_CAP) { atomicAdd(&bar[XB_TMO], 1u); break; } }
  }
  nloc = mine > 0u ? mine : 1u; nx = cnt > 0u ? cnt : 1u;
}
DI void xcd_barrier(const XcdBarrier& b) {
  asm volatile("s_waitcnt vmcnt(0)" ::: "memory");
  __syncthreads();
  if (threadIdx.x == 0) {
    unsigned* bar = b.bar;
    __builtin_amdgcn_s_waitcnt(0);
    unsigned nloc = b.st[0], nx = b.st[1];
    if (nloc == 0u) { xcd_barrier_complete(bar, b.x, nloc, nx); b.st[0] = nloc; b.st[1] = nx; }
    const unsigned old = xb_add(&bar[XB_XSUB(b.x)], 1u);
    const unsigned gen = old / nloc;
    if (old + 1u == (gen + 1u) * nloc) {
      __builtin_amdgcn_fence(__ATOMIC_RELEASE, "agent");
      asm volatile("s_waitcnt vmcnt(0)" ::: "memory");
      const unsigned og = xb_add(&bar[XB_TOP], 1u);
      const unsigned tg = og / nx;
      if (og + 1u == (tg + 1u) * nx) xb_add(&bar[XB_TOPGEN], 1u);
      else XB_SPIN(xb_ld(&bar[XB_TOPGEN]) == tg, bar);
      __builtin_amdgcn_fence(__ATOMIC_ACQUIRE, "agent");
      xb_add(&bar[XB_XGEN(b.x)], 1u);
      asm volatile("s_waitcnt vmcnt(0)" ::: "memory");
    } else {
      XB_SPIN(xb_ld(&bar[XB_XGEN(b.x)]) == gen, bar);
      __builtin_amdgcn_fence(__ATOMIC_ACQUIRE, "agent");
      asm volatile("s_waitcnt vmcnt(0)" ::: "memory");
    }
  }
  __syncthreads();
}

DI void gemm_kloop(const u16* __restrict__ A, size_t lda, const u16* __restrict__ Bt, size_t ldb, int K,
                   f32x4 (&acc)[4][4], char* sm, int tid) {
  const int lane = tid & 63, wave = __builtin_amdgcn_readfirstlane(tid >> 6), wm = wave >> 1, wn = wave & 1;
  const int lr = tid >> 2, lkc = tid & 3;
  const u16* Ap = A + (size_t)lr * lda + lkc * 8;
  const u16* Bp = Bt + (size_t)lr * ldb + lkc * 8;
  const int woff0 = lds_off(lr, lkc * 8), woff1 = lds_off(lr + 64, lkc * 8), woff2 = lds_off(lr, 32 + lkc * 8),
            woff3 = lds_off(lr + 64, 32 + lkc * 8);
  int aoff[4][2], boff[4][2];
#pragma unroll
  for (int m = 0; m < 4; ++m)
#pragma unroll
    for (int kk = 0; kk < 2; ++kk) {
      aoff[m][kk] = lds_off(wm * 64 + m * 16 + (lane & 15), kk * 32 + (lane >> 4) * 8);
      boff[m][kk] = lds_off(wn * 64 + m * 16 + (lane & 15), kk * 32 + (lane >> 4) * 8);
    }
  const int nk = K >> 6;
  uint4 pa0, pa1, pa2, pa3, pb0, pb1, pb2, pb3;
  uint4 qa0, qa1, qa2, qa3, qb0, qb1, qb2, qb3;
#define G_LOAD(S, KT)                                                                        \
  {                                                                                          \
    S##a0 = *reinterpret_cast<const uint4*>(Ap + (KT) * 64);                                 \
    S##a1 = *reinterpret_cast<const uint4*>(Ap + (size_t)64 * lda + (KT) * 64);              \
    S##a2 = *reinterpret_cast<const uint4*>(Ap + (KT) * 64 + 32);                            \
    S##a3 = *reinterpret_cast<const uint4*>(Ap + (size_t)64 * lda + (KT) * 64 + 32);         \
    S##b0 = *reinterpret_cast<const uint4*>(Bp + (KT) * 64);                                 \
    S##b1 = *reinterpret_cast<const uint4*>(Bp + (size_t)64 * ldb + (KT) * 64);              \
    S##b2 = *reinterpret_cast<const uint4*>(Bp + (KT) * 64 + 32);                            \
    S##b3 = *reinterpret_cast<const uint4*>(Bp + (size_t)64 * ldb + (KT) * 64 + 32);         \
  }
#define G_STORE(S, BUF)                                                                      \
  {                                                                                          \
    char* da_ = sm + (BUF) * 16384;                                                          \
    *reinterpret_cast<uint4*>(da_ + woff0) = S##a0;                                          \
    *reinterpret_cast<uint4*>(da_ + woff1) = S##a1;                                          \
    *reinterpret_cast<uint4*>(da_ + woff2) = S##a2;                                          \
    *reinterpret_cast<uint4*>(da_ + woff3) = S##a3;                                          \
    *reinterpret_cast<uint4*>(da_ + 32768 + woff0) = S##b0;                                  \
    *reinterpret_cast<uint4*>(da_ + 32768 + woff1) = S##b1;                                  \
    *reinterpret_cast<uint4*>(da_ + 32768 + woff2) = S##b2;                                  \
    *reinterpret_cast<uint4*>(da_ + 32768 + woff3) = S##b3;                                  \
  }
#define G_COMPUTE(BUF)                                                                       \
  {                                                                                          \
    const char* sa = sm + (BUF) * 16384;                                                     \
    const char* sb = sm + 32768 + (BUF) * 16384;                                             \
    _Pragma("unroll") for (int kk = 0; kk < 2; ++kk) {                                       \
      bf16x8 af[4], bfr[4];                                                                  \
      _Pragma("unroll") for (int m = 0; m < 4; ++m) af[m] = *reinterpret_cast<const bf16x8*>(sa + aoff[m][kk]);  \
      _Pragma("unroll") for (int n = 0; n < 4; ++n) bfr[n] = *reinterpret_cast<const bf16x8*>(sb + boff[n][kk]); \
      _Pragma("unroll") for (int m = 0; m < 4; ++m)                                          \
        _Pragma("unroll") for (int n = 0; n < 4; ++n)                                        \
          acc[m][n] = __builtin_amdgcn_mfma_f32_16x16x32_bf16(bfr[n], af[m], acc[m][n], 0, 0, 0);                \
    }                                                                                        \
  }
  const int nkm1 = nk - 1;
  G_LOAD(p, 0)
  G_STORE(p, 0)
  G_LOAD(p, 1)
  __builtin_amdgcn_sched_barrier(0);
  G_LOAD(q, min(2, nkm1))
  __builtin_amdgcn_sched_barrier(0);
  __syncthreads();
  for (int kt = 0; kt < nk; kt += 2) {
    G_COMPUTE(0)
    G_STORE(p, 1)
    G_LOAD(p, min(kt + 3, nkm1))
    __syncthreads();
    G_COMPUTE(1)
    G_STORE(q, 0)
    G_LOAD(q, min(kt + 4, nkm1))
    __syncthreads();
  }
}

#define GREGS_DECL uint4 g_pa0, g_pa1, g_pa2, g_pa3, g_pb0, g_pb1, g_pb2, g_pb3, g_qa0, g_qa1, g_qa2, g_qa3, g_qb0, g_qb1, g_qb2, g_qb3
#define GREGS_PARAMS uint4 &g_pa0, uint4 &g_pa1, uint4 &g_pa2, uint4 &g_pa3, uint4 &g_pb0, uint4 &g_pb1, uint4 &g_pb2, uint4 &g_pb3, uint4 &g_qa0, uint4 &g_qa1, uint4 &g_qa2, uint4 &g_qa3, uint4 &g_qb0, uint4 &g_qb1, uint4 &g_qb2, uint4 &g_qb3
#define GREGS_ARGS g_pa0, g_pa1, g_pa2, g_pa3, g_pb0, g_pb1, g_pb2, g_pb3, g_qa0, g_qa1, g_qa2, g_qa3, g_qb0, g_qb1, g_qb2, g_qb3
DI void gemm_stream(const u16* __restrict__ A, const u16* __restrict__ Bt, const u16* __restrict__ An,
                    const u16* __restrict__ Btn, size_t lda, size_t ldb, int K, bool first, f32x4 (&acc)[4][4], GREGS_PARAMS,
                    char* sm, int tid) {
  const int lane = tid & 63, wave = __builtin_amdgcn_readfirstlane(tid >> 6), wm = wave >> 1, wn = wave & 1;
  const int lr = tid >> 2, lkc = tid & 3;
  const u16* Ap = A + (size_t)lr * lda + lkc * 8;
  const u16* Bp = Bt + (size_t)lr * ldb + lkc * 8;
  const u16* Apn = An + (size_t)lr * lda + lkc * 8;
  const u16* Bpn = Btn + (size_t)lr * ldb + lkc * 8;
  const int woff0 = lds_off(lr, lkc * 8), woff1 = lds_off(lr + 64, lkc * 8), woff2 = lds_off(lr, 32 + lkc * 8),
            woff3 = lds_off(lr + 64, 32 + lkc * 8);
  int aoff[4][2], boff[4][2];
#pragma unroll
  for (int m = 0; m < 4; ++m)
#pragma unroll
    for (int kk = 0; kk < 2; ++kk) {
      aoff[m][kk] = lds_off(wm * 64 + m * 16 + (lane & 15), kk * 32 + (lane >> 4) * 8);
      boff[m][kk] = lds_off(wn * 64 + m * 16 + (lane & 15), kk * 32 + (lane >> 4) * 8);
    }
  const int nk = K >> 6;
#define S_LOAD(S, IDX)                                                                       \
  {                                                                                          \
    const int ix_ = (IDX);                                                                   \
    const u16* a_ = ix_ < nk ? Ap + ix_ * 64 : Apn + (ix_ - nk) * 64;                        \
    const u16* b_ = ix_ < nk ? Bp + ix_ * 64 : Bpn + (ix_ - nk) * 64;                        \
    g_##S##a0 = *reinterpret_cast<const uint4*>(a_);                                           \
    g_##S##a1 = *reinterpret_cast<const uint4*>(a_ + (size_t)64 * lda);                        \
    g_##S##a2 = *reinterpret_cast<const uint4*>(a_ + 32);                                      \
    g_##S##a3 = *reinterpret_cast<const uint4*>(a_ + (size_t)64 * lda + 32);                   \
    g_##S##b0 = *reinterpret_cast<const uint4*>(b_);                                           \
    g_##S##b1 = *reinterpret_cast<const uint4*>(b_ + (size_t)64 * ldb);                        \
    g_##S##b2 = *reinterpret_cast<const uint4*>(b_ + 32);                                      \
    g_##S##b3 = *reinterpret_cast<const uint4*>(b_ + (size_t)64 * ldb + 32);                   \
  }
#define S_STORE(S, BUF)                                                                      \
  {                                                                                          \
    char* da_ = sm + (BUF) * 16384;                                                          \
    *reinterpret_cast<uint4*>(da_ + woff0) = g_##S##a0;                                        \
    *reinterpret_cast<uint4*>(da_ + woff1) = g_##S##a1;                                        \
    *reinterpret_cast<uint4*>(da_ + woff2) = g_##S##a2;                                        \
    *reinterpret_cast<uint4*>(da_ + woff3) = g_##S##a3;                                        \
    *reinterpret_cast<uint4*>(da_ + 32768 + woff0) = g_##S##b0;                                \
    *reinterpret_cast<uint4*>(da_ + 32768 + woff1) = g_##S##b1;                                \
    *reinterpret_cast<uint4*>(da_ + 32768 + woff2) = g_##S##b2;                                \
    *reinterpret_cast<uint4*>(da_ + 32768 + woff3) = g_##S##b3;                                \
  }
  if (first) {
    S_LOAD(p, 0)
    S_STORE(p, 0)
    S_LOAD(p, 1)
    __builtin_amdgcn_sched_barrier(0);
    S_LOAD(q, 2)
    __builtin_amdgcn_sched_barrier(0);
    __syncthreads();
  }
  for (int kt = 0; kt < nk; kt += 2) {
    G_COMPUTE(0)
    S_STORE(p, 1)
    S_LOAD(p, kt + 3)
    __syncthreads();
    G_COMPUTE(1)
    S_STORE(q, 0)
    S_LOAD(q, kt + 4)
    __syncthreads();
  }
}

DI void glds16(const u16* g, char* l) {
  __builtin_amdgcn_global_load_lds(reinterpret_cast<const unsigned*>(g), reinterpret_cast<unsigned*>(l), 16, 0, 0);
}
DI void gemm_dma(const u16* __restrict__ A, const u16* __restrict__ Bt, const u16* __restrict__ An,
                 const u16* __restrict__ Btn, size_t lda, size_t ldb, int K, bool first, f32x4 (&acc)[4][4], char* sm,
                 int tid) {
  const int lane = tid & 63, wave = __builtin_amdgcn_readfirstlane(tid >> 6), wm = wave >> 1, wn = wave & 1;
  const int sb = lane * 16, swz = sb ^ (((sb >> 9) & 1) << 5);
  const int R0 = (wave >> 1) * 16 + (swz >> 6), C = (wave & 1) * 32 + ((swz & 63) >> 1);
  const u16* Ap = A + (size_t)R0 * lda + C;
  const u16* Bp = Bt + (size_t)R0 * ldb + C;
  const u16* Apn = An + (size_t)R0 * lda + C;
  const u16* Bpn = Btn + (size_t)R0 * ldb + C;
  char* l0 = sm + tid * 16;
  int aoff[4][2], boff[4][2];
#pragma unroll
  for (int m = 0; m < 4; ++m)
#pragma unroll
    for (int kk = 0; kk < 2; ++kk) {
      aoff[m][kk] = lds_off(wm * 64 + m * 16 + (lane & 15), kk * 32 + (lane >> 4) * 8);
      boff[m][kk] = lds_off(wn * 64 + m * 16 + (lane & 15), kk * 32 + (lane >> 4) * 8);
    }
  const int nk = K >> 6;
#define D_LOAD(IDX, BUF)                                                                     \
  {                                                                                          \
    const int ix_ = (IDX);                                                                   \
    const u16* a_ = ix_ < nk ? Ap + ix_ * 64 : Apn;                                          \
    const u16* b_ = ix_ < nk ? Bp + ix_ * 64 : Bpn;                                          \
    char* la_ = l0 + (BUF) * 16384;                                                          \
    glds16(a_, la_);                                                                         \
    glds16(a_ + (size_t)32 * lda, la_ + 4096);                                               \
    glds16(a_ + (size_t)64 * lda, la_ + 8192);                                               \
    glds16(a_ + (size_t)96 * lda, la_ + 12288);                                              \
    glds16(b_, la_ + 32768);                                                                 \
    glds16(b_ + (size_t)32 * ldb, la_ + 32768 + 4096);                                       \
    glds16(b_ + (size_t)64 * ldb, la_ + 32768 + 8192);                                       \
    glds16(b_ + (size_t)96 * ldb, la_ + 32768 + 12288);                                      \
  }
#define D_STEP(BUF, IDX, NBUF)                                                               \
  {                                                                                          \
    const char* sa = sm + (BUF) * 16384;                                                     \
    const char* sb = sm + 32768 + (BUF) * 16384;                                             \
    bf16x8 af[2][4], bfr[2][4];                                                              \
    __builtin_amdgcn_s_setprio(3);        \
    _Pragma("unroll") for (int kk = 0; kk < 2; ++kk) {                                       \
      _Pragma("unroll") for (int m = 0; m < 4; ++m) af[kk][m] = *reinterpret_cast<const bf16x8*>(sa + aoff[m][kk]);  \
      _Pragma("unroll") for (int n = 0; n < 4; ++n) bfr[kk][n] = *reinterpret_cast<const bf16x8*>(sb + boff[n][kk]); \
    }                                                                                        \
    __builtin_amdgcn_sched_barrier(0);                                                       \
    D_LOAD(IDX, NBUF)                                                                        \
    __builtin_amdgcn_s_setprio(0);                                                           \
    __builtin_amdgcn_sched_barrier(0);                                                       \
    _Pragma("unroll") for (int kk = 0; kk < 2; ++kk)                                         \
      _Pragma("unroll") for (int m = 0; m < 4; ++m)                                          \
        _Pragma("unroll") for (int n = 0; n < 4; ++n)                                        \
          acc[m][n] = __builtin_amdgcn_mfma_f32_16x16x32_bf16(bfr[kk][n], af[kk][m], acc[m][n], 0, 0, 0);           \
    __builtin_amdgcn_sched_barrier(0);    \
  }
  if (first) {
    D_LOAD(0, 0)
    __syncthreads();
  }
  for (int kt = 0; kt < nk; kt += 2) {
    D_STEP(0, kt + 1, 1)
    __syncthreads();
    D_STEP(1, kt + 2, 0)
    __syncthreads();
  }
}

DI void acc_zero(f32x4 (&acc)[4][4]) {
#pragma unroll
  for (int m = 0; m < 4; ++m)
#pragma unroll
    for (int n = 0; n < 4; ++n) acc[m][n] = f32x4{0.f, 0.f, 0.f, 0.f};
}

#define EPI_LOOP(BODY)                                                                   \
  {                                                                                      \
    const int lane_ = tid & 63, wave_ = __builtin_amdgcn_readfirstlane(tid >> 6), wm_ = wave_ >> 1, wn_ = wave_ & 1;     \
    _Pragma("unroll") for (int m = 0; m < 4; ++m) {                                      \
      const int row = wm_ * 64 + m * 16 + (lane_ & 15);                                  \
      _Pragma("unroll") for (int n = 0; n < 4; ++n) {                                    \
        const int col = wn_ * 64 + n * 16 + (lane_ >> 4) * 4;                            \
        f32x4& v = acc[m][n];                                                            \
        BODY                                                                             \
      }                                                                                  \
    }                                                                                    \
  }

DI void store_bf4(u16* p, float a, float b, float c, float d) {
  uint2 u;
  u.x = pk2(a, b);
  u.y = pk2(c, d);
  *reinterpret_cast<uint2*>(p) = u;
}

#define XCD_TILE_LOOP(MT, NT8)                                                                        \
  const int xcd_ = blockIdx.x & 7, slot_ = blockIdx.x >> 3, nslots_ = gridDim.x >> 3;                 \
  const int mlo_ = (xcd_ * 132) >> 3, mhi_ = ((xcd_ + 1) * 132) >> 3;                                 \
  for (int it_ = slot_, MT = mlo_ + (slot_ >> 3), NT8 = slot_ & 7; it_ < (mhi_ - mlo_) * 8;           \
       it_ += nslots_, MT = mlo_ + (it_ >> 3), NT8 = it_ & 7)

#define XCD_TILE_LOOP_N(MT, NT8, MTN, NTN)                                                            \
  const int xcd_ = blockIdx.x & 7, slot_ = blockIdx.x >> 3, nslots_ = gridDim.x >> 3;                 \
  const int mlo_ = (xcd_ * 132) >> 3, mhi_ = ((xcd_ + 1) * 132) >> 3, lim_ = (mhi_ - mlo_) * 8;        \
  for (int it_ = slot_, itn_ = (slot_ + nslots_ < lim_ ? slot_ + nslots_ : slot_), MT = mlo_ + (it_ >> 3), NT8 = it_ & 7, \
           MTN = mlo_ + (itn_ >> 3), NTN = itn_ & 7;                                                  \
       it_ < lim_;                                                                                    \
       it_ += nslots_, itn_ = (it_ + nslots_ < lim_ ? it_ + nslots_ : it_), MT = mlo_ + (it_ >> 3), NT8 = it_ & 7, \
           MTN = mlo_ + (itn_ >> 3), NTN = itn_ & 7)

DI void convT_tile(const float* __restrict__ src, int ldsrc, int k0, int srccol0, u16* __restrict__ dst, int K,
                   int dstn0, const float* __restrict__ scale, float* sm, int tid) {
  float vv[16];
#pragma unroll
  for (int i = 0; i < 16; ++i) {
    const int k = i * 4 + (tid >> 6);
    float v = src[(size_t)(k0 + k) * ldsrc + srccol0 + (tid & 63)];
    if (scale) v *= scale[k0 + k];
    vv[i] = v;
  }
#pragma unroll
  for (int i = 0; i < 16; ++i) sm[(i * 4 + (tid >> 6)) * 65 + (tid & 63)] = vv[i];
  __syncthreads();
#pragma unroll
  for (int ps = 0; ps < 2; ++ps) {
    const int n = ps * 32 + (tid >> 3), kc = tid & 7;
    const float* c = sm + (kc * 8) * 65 + n;
    uint4 u;
    u.x = pk2(c[0], c[65]); u.y = pk2(c[2 * 65], c[3 * 65]); u.z = pk2(c[4 * 65], c[5 * 65]); u.w = pk2(c[6 * 65], c[7 * 65]);
    *reinterpret_cast<uint4*>(dst + (size_t)(dstn0 + n) * K + k0 + kc * 8) = u;
  }
  __syncthreads();
}

__device__ void phase_convert_weights(const Params& p, char* smem, int tid) {
  float* sm = reinterpret_cast<float*>(smem);
  for (int it = blockIdx.x; it < 6400; it += gridDim.x) {
    if (it < 4096) {
      int l = it >> 11, r = it & 2047, kt = r >> 7, nt = r & 127;
      int n0 = nt * 64;
      int srccol = n0 < 4096 ? n0 : n0 + 16;
      convT_tile(p.w_in + (size_t)l * 1024 * INW, INW, kt * 64, srccol,
                 reinterpret_cast<u16*>(p.ws + OFF_WIN) + (size_t)l * 8192 * 1024, 1024, n0, p.norm_mix + l * 1024, sm,
                 tid);
    } else if (it < 6144) {
      int r = it - 4096, which = r >> 9, l = (r >> 8) & 1, tt = r & 255, kt = tt >> 4, nt = tt & 15;
      const float* src = which == 0 ? p.w_proj_a : which == 1 ? p.w_proj_b : which == 2 ? p.w_out : p.w_ple_gate;
      size_t off = which == 0 ? OFF_WA : which == 1 ? OFF_WB : which == 2 ? OFF_WO : OFF_WG;
      convT_tile(src + (size_t)l * 1024 * 1024, 1024, kt * 64, nt * 64,
                 reinterpret_cast<u16*>(p.ws + off) + (size_t)l * 1024 * 1024, 1024, nt * 64,
                 which == 3 ? p.norm_ple + l * 1024 : nullptr, sm, tid);
    } else if (it < 6272) {
      int r = it - 6144, l = r >> 6, tt = r & 63, kt = tt >> 4, nt = tt & 15;
      convT_tile(p.w_ple_proj + (size_t)l * 256 * 1024, 1024, kt * 64, nt * 64,
                 reinterpret_cast<u16*>(p.ws + OFF_WP) + (size_t)l * 1024 * 256, 256, nt * 64, nullptr, sm, tid);
    } else {
      int r = it - 6272, lg = r >> 4, tt = r & 15, kt = tt >> 2, nt = tt & 3;
      convT_tile(p.pool_w + (size_t)lg * 256 * 256, 256, kt * 64, nt * 64,
                 reinterpret_cast<u16*>(p.ws + OFF_WPL) + (size_t)lg * 256 * 256, 256, nt * 64, nullptr, sm, tid);
    }
  }
}

__device__ void phase_prep(const Params& p, int l, char* smem, int tid) {
  float* sW = reinterpret_cast<float*>(smem);
  const float* win = p.w_in + (size_t)l * 1024 * INW;
  const float* nm = p.norm_mix + l * 1024;
  for (int i = 0; i < 64; ++i) {
    int idx = tid + 256 * i;
    int k = idx >> 4, j = idx & 15;
    sW[j * 1024 + k] = win[(size_t)k * INW + 4096 + j] * nm[k];
  }
  __syncthreads();
  const int lane = tid & 63, wave = __builtin_amdgcn_readfirstlane(tid >> 6);
  u16* hb = reinterpret_cast<u16*>(p.ws + OFF_H);
  u16* pb = reinterpret_cast<u16*>(p.ws + OFF_PB);
  float* gbuf = reinterpret_cast<float*>(p.ws + OFF_G);
  float* bbuf = reinterpret_cast<float*>(p.ws + OFF_BETA);
  auto rowptr = [&](int r) -> const float* {
    if (l == 0) return r < TP ? p.x_prompt + (size_t)r * 1024 : p.x_sample + (size_t)(r - TP) * 1024;
    return p.out + (size_t)r * 1024;
  };
  int r = blockIdx.x * 4 + wave;
  float4 xn0 = {0.f, 0.f, 0.f, 0.f}, xn1 = xn0, xn2 = xn0, xn3 = xn0;
  if (r < T) {
    const float* xr = rowptr(r);
    xn0 = *reinterpret_cast<const float4*>(xr + lane * 4);
    xn1 = *reinterpret_cast<const float4*>(xr + 256 + lane * 4);
    xn2 = *reinterpret_cast<const float4*>(xr + 512 + lane * 4);
    xn3 = *reinterpret_cast<const float4*>(xr + 768 + lane * 4);
  }
  for (; r < T; r += gridDim.x * 4) {
    float4 xv[4] = {xn0, xn1, xn2, xn3};
    const float* prow = r < TP ? p.p_prompt + ((size_t)l * TP + r) * 256 : p.p_sample + ((size_t)l * TS + (r - TP)) * 256;
    const float4 pv = *reinterpret_cast<const float4*>(prow + lane * 4);
    const int rn = r + gridDim.x * 4;
    if (rn < T) {
      const float* xr = rowptr(rn);
      xn0 = *reinterpret_cast<const float4*>(xr + lane * 4);
      xn1 = *reinterpret_cast<const float4*>(xr + 256 + lane * 4);
      xn2 = *reinterpret_cast<const float4*>(xr + 512 + lane * 4);
      xn3 = *reinterpret_cast<const float4*>(xr + 768 + lane * 4);
    }
    float ss = 0.f;
#pragma unroll
    for (int i = 0; i < 4; ++i) ss += xv[i].x * xv[i].x + xv[i].y * xv[i].y + xv[i].z * xv[i].z + xv[i].w * xv[i].w;
    float d[16];
#pragma unroll
    for (int j = 0; j < 16; ++j) d[j] = 0.f;
#pragma unroll
    for (int i = 0; i < 4; ++i) {
#pragma unroll
      for (int j = 0; j < 16; ++j) {
        float4 w = *reinterpret_cast<const float4*>(sW + j * 1024 + i * 256 + lane * 4);
        d[j] += xv[i].x * w.x + xv[i].y * w.y + xv[i].z * w.z + xv[i].w * w.w;
      }
      __builtin_amdgcn_sched_barrier(0);
    }
    ss = wave_sum(ss);
    float k8[8], k4[4], k2[2], k1;
#pragma unroll
    for (int i = 0; i < 8; ++i) {
      const float send = (lane & 32) ? d[i] : d[i + 8], keep = (lane & 32) ? d[i + 8] : d[i];
      k8[i] = keep + __shfl_xor(send, 32);
    }
#pragma unroll
    for (int i = 0; i < 4; ++i) {
      const float send = (lane & 16) ? k8[i] : k8[i + 4], keep = (lane & 16) ? k8[i + 4] : k8[i];
      k4[i] = keep + __shfl_xor(send, 16);
    }
#pragma unroll
    for (int i = 0; i < 2; ++i) {
      const float send = (lane & 8) ? k4[i] : k4[i + 2], keep = (lane & 8) ? k4[i + 2] : k4[i];
      k2[i] = keep + __shfl_xor(send, 8);
    }
    {
      const float send = (lane & 4) ? k2[0] : k2[1], keep = (lane & 4) ? k2[1] : k2[0];
      k1 = keep + __shfl_xor(send, 4);
    }
    k1 += __shfl_xor(k1, 2);
    k1 += __shfl_xor(k1, 1);
    const float rstd = rsqrtf(ss * (1.f / 1024.f) + EPS);
#pragma unroll
    for (int i = 0; i < 4; ++i)
      store_bf4(hb + (size_t)r * 1024 + i * 256 + lane * 4, xv[i].x * rstd, xv[i].y * rstd, xv[i].z * rstd, xv[i].w * rstd);
    if ((lane & 3) == 0) {
      const int j = ((lane >> 5) & 1) * 8 + ((lane >> 4) & 1) * 4 + ((lane >> 3) & 1) * 2 + ((lane >> 2) & 1);
      const float val = k1 * rstd;
      if (j < 8) {
        float xx = val + p.dt_bias[l * 8 + j];
        float sp = xx > 20.f ? xx : log1pf(__expf(xx));
        gbuf[(size_t)r * 8 + j] = -__expf(p.a_log[l * 8 + j]) * sp;
      } else {
        bbuf[(size_t)r * 8 + (j - 8)] = sigmoidf_(val);
      }
    }
    store_bf4(pb + (size_t)r * 256 + lane * 4, pv.x, pv.y, pv.z, pv.w);
  }
}

__device__ void phase_final(const Params& p, int tid) {
  const int lane = tid & 63, wave = __builtin_amdgcn_readfirstlane(tid >> 6);
  for (int r = blockIdx.x * 4 + wave; r < T; r += gridDim.x * 4) {
    float* xrow = p.out + (size_t)r * 1024;
    float4 xv[4];
    float ss = 0.f;
#pragma unroll
    for (int i = 0; i < 4; ++i) {
      xv[i] = *reinterpret_cast<const float4*>(xrow + i * 256 + lane * 4);
      ss += xv[i].x * xv[i].x + xv[i].y * xv[i].y + xv[i].z * xv[i].z + xv[i].w * xv[i].w;
    }
    ss = wave_sum(ss);
    const float rstd = rsqrtf(ss * (1.f / 1024.f) + EPS);
#pragma unroll
    for (int i = 0; i < 4; ++i) {
      float4 w = *reinterpret_cast<const float4*>(p.final_norm + i * 256 + lane * 4);
      float4 o;
      o.x = xv[i].x * rstd * w.x; o.y = xv[i].y * rstd * w.y; o.z = xv[i].z * rstd * w.z; o.w = xv[i].w * rstd * w.w;
      *reinterpret_cast<float4*>(xrow + i * 256 + lane * 4) = o;
    }
  }
}

__device__ void phase_inproj(const Params& p, int l, char* smem, int tid) {
  const u16* hb = reinterpret_cast<const u16*>(p.ws + OFF_H);
  const u16* W = reinterpret_cast<const u16*>(p.ws + OFF_WIN) + (size_t)l * 8192 * 1024;
  u16* P1 = reinterpret_cast<u16*>(p.ws + OFF_P1);
  const int xcd = blockIdx.x & 7, slot = blockIdx.x >> 3, nslots = gridDim.x >> 3;
  GREGS_DECL;
  bool first = true;
  for (int it = slot; it < 132 * 8; it += nslots) {
    const int mt = it >> 3, nt = xcd * 8 + (it & 7);
    const int itn = (it + nslots < 132 * 8) ? it + nslots : it;
    const int mtn = itn >> 3, ntn = xcd * 8 + (itn & 7);
    f32x4 acc[4][4];
    acc_zero(acc);
    gemm_dma(hb + (size_t)mt * 128 * 1024, W + (size_t)nt * 128 * 1024, hb + (size_t)mtn * 128 * 1024,
                W + (size_t)ntn * 128 * 1024, 1024, 1024, 1024, first, acc, smem, tid);
    first = false;
    u16* dst;
    size_t ld;
    if (nt < 24) { dst = P1 + (size_t)mt * 128 * 3072 + nt * 128; ld = 3072; }
    else {
      const int arr = (nt - 24) >> 3;
      const size_t off = arr == 0 ? OFF_Z : arr == 1 ? OFF_U : arr == 2 ? OFF_GP : arr == 3 ? OFF_GA : OFF_GB;
      dst = reinterpret_cast<u16*>(p.ws + off) + (size_t)mt * 128 * 1024 + ((nt - 24) & 7) * 128; ld = 1024;
    }
    EPI_LOOP({ store_bf4(dst + (size_t)row * ld + col, v[0], v[1], v[2], v[3]); })
  }
}

__device__ void phase_conv_pool(const Params& p, int l, char* smem, int tid, int mode = 3) {
  const int lane = tid & 63, wave = __builtin_amdgcn_readfirstlane(tid >> 6);
  const u16* P1 = reinterpret_cast<const u16*>(p.ws + OFF_P1);
  const u16* Ub = reinterpret_cast<const u16*>(p.ws + OFF_U);
  u16* ypre = reinterpret_cast<u16*>(p.ws + OFF_Y);
  const int n_prompt = 256 * 24;
  const int n_conv = n_prompt + 128 * 24;
  if (mode & 1)
  for (int wt = blockIdx.x * 4 + wave; wt < n_conv; wt += gridDim.x * 4) {
    const bool smp = wt >= n_prompt;
    int run, j;
    if (!smp) { run = wt / 24; j = wt % 24; } else { run = (wt - n_prompt) / 24; j = (wt - n_prompt) % 24; }
    const int col = j * 128 + lane * 2;
    const int hh = j & 7, ten = j >> 3;
    const float* cw = p.conv_w + (size_t)l * 4 * 3072 + col;
    const float2 w0 = *reinterpret_cast<const float2*>(cw);
    const float2 w1 = *reinterpret_cast<const float2*>(cw + 3072);
    const float2 w2 = *reinterpret_cast<const float2*>(cw + 2 * 3072);
    const float2 w3 = *reinterpret_cast<const float2*>(cw + 3 * 3072);
    u16* tokmaj = reinterpret_cast<u16*>(p.ws + (ten == 0 ? OFF_QA : ten == 1 ? OFF_KA : OFF_VA));
    float2 x0 = {0.f, 0.f}, x1 = {0.f, 0.f}, x2 = {0.f, 0.f};
    if (!smp) {
      const int b = run >> 5, t0 = (run & 31) * 64;
      const int ts = lane >> 4, c8 = lane & 15;
      const int seg0 = t0 + ts * 16;
      const size_t rowb = (size_t)b * 2048 + seg0;
      const int col8 = j * 128 + c8 * 8;
      char* stg = smem + wave * 16384;
      float wc[4][8];
#pragma unroll
      for (int r = 0; r < 4; ++r) {
        const float4 wa = *reinterpret_cast<const float4*>(p.conv_w + (size_t)l * 4 * 3072 + r * 3072 + col8);
        const float4 wb = *reinterpret_cast<const float4*>(p.conv_w + (size_t)l * 4 * 3072 + r * 3072 + col8 + 4);
        wc[r][0] = wa.x; wc[r][1] = wa.y; wc[r][2] = wa.z; wc[r][3] = wa.w;
        wc[r][4] = wb.x; wc[r][5] = wb.y; wc[r][6] = wb.z; wc[r][7] = wb.w;
      }
      const u16* src = P1 + rowb * 3072 + col8;
      float xw[3][8];
      {
        uint4 h0 = {0u, 0u, 0u, 0u}, h1 = h0, h2 = h0;
        if (seg0 > 0) {
          h0 = *reinterpret_cast<const uint4*>(src - (size_t)3 * 3072);
          h1 = *reinterpret_cast<const uint4*>(src - (size_t)2 * 3072);
          h2 = *reinterpret_cast<const uint4*>(src - (size_t)1 * 3072);
        }
#define UNPK8(DST, U) { DST[0] = bflo(U.x); DST[1] = bfhi(U.x); DST[2] = bflo(U.y); DST[3] = bfhi(U.y); \
                        DST[4] = bflo(U.z); DST[5] = bfhi(U.z); DST[6] = bflo(U.w); DST[7] = bfhi(U.w); }
        UNPK8(xw[0], h0) UNPK8(xw[1], h1) UNPK8(xw[2], h2)
      }
      uint4 rall[16];
#pragma unroll
      for (int i = 0; i < 16; ++i) rall[i] = *reinterpret_cast<const uint4*>(src + (size_t)i * 3072);
#pragma unroll
      for (int qb = 0; qb < 4; ++qb) {
        uint4 rows[4];
#pragma unroll
        for (int i = 0; i < 4; ++i) rows[i] = rall[qb * 4 + i];
        float o[4][8];
        float ss[4];
#pragma unroll
        for (int i = 0; i < 4; ++i) {
          float x3[8];
          UNPK8(x3, rows[i])
          float sacc = 0.f;
#pragma unroll
          for (int c = 0; c < 8; ++c) {
            float v = xw[0][c] * wc[0][c] + xw[1][c] * wc[1][c] + xw[2][c] * wc[2][c] + x3[c] * wc[3][c];
            v = siluf_(v);
            o[i][c] = v;
            sacc += v * v;
            xw[0][c] = xw[1][c]; xw[1][c] = xw[2][c]; xw[2][c] = x3[c];
          }
          ss[i] = sacc;
          const int tseq = seg0 + qb * 4 + i;
          if (tseq >= 2045) {
            float* po = p.out + O_CONVP + ((size_t)(l * 8 + b) * 3 + (tseq - 2045)) * 3072 + col8;
            *reinterpret_cast<float4*>(po) = float4{x3[0], x3[1], x3[2], x3[3]};
            *reinterpret_cast<float4*>(po + 4) = float4{x3[4], x3[5], x3[6], x3[7]};
          }
        }
        if (ten < 2) {
#pragma unroll
          for (int ofs = 8; ofs >= 1; ofs >>= 1) {
#pragma unroll
            for (int i = 0; i < 4; ++i) ss[i] += __shfl_xor(ss[i], ofs);
          }
#pragma unroll
          for (int i = 0; i < 4; ++i) {
            float sc = rsqrtf(ss[i] + EPS);
            if (ten == 0) sc *= 0.08838834764831845f;
#pragma unroll
            for (int c = 0; c < 8; ++c) o[i][c] *= sc;
            uint4 w;
            w.x = pk2(o[i][0], o[i][1]); w.y = pk2(o[i][2], o[i][3]); w.z = pk2(o[i][4], o[i][5]); w.w = pk2(o[i][6], o[i][7]);
            *reinterpret_cast<uint4*>(tokmaj + (rowb + qb * 4 + i) * 1024 + hh * 128 + c8 * 8) = w;
          }
        }
        if (ten >= 1) {
          const int chunk8 = ts * 4 + qb;
#pragma unroll
          for (int c = 0; c < 8; ++c) {
            const int ch = c8 * 8 + c;
            uint2 w;
            w.x = pk2(o[0][c], o[1][c]); w.y = pk2(o[2][c], o[3][c]);
            *reinterpret_cast<uint2*>(stg + ch * 128 + (((chunk8 >> 1) ^ (c8 & 7)) * 16) + (chunk8 & 1) * 8) = w;
          }
        }
        __builtin_amdgcn_sched_barrier(0);
      }
      if (ten >= 1) {
        asm volatile("s_waitcnt lgkmcnt(0)" ::: "memory");
        u16* tr = reinterpret_cast<u16*>(p.ws + (ten == 1 ? OFF_KT : OFF_VA)) + ((size_t)(b * 8 + hh) * 128) * 2048 + t0;
#pragma unroll 4
        for (int k = 0; k < 16; ++k) {
          const int pc = lane + 64 * k, ch = pc >> 3, c = pc & 7;
          const uint4 v = *reinterpret_cast<const uint4*>(stg + ch * 128 + ((c ^ ((ch >> 3) & 7)) * 16));
          *reinterpret_cast<uint4*>(tr + (unsigned)(ch * 2048 + c * 8)) = v;
        }
        asm volatile("s_waitcnt lgkmcnt(0)" ::: "memory");
      }
    } else {
      const int b = run, base = TP + b * 4;
      const float* sc0 = p.state_conv + ((size_t)(l * 128 + b) * 3) * 3072 + col;
      x0 = *reinterpret_cast<const float2*>(sc0);
      x1 = *reinterpret_cast<const float2*>(sc0 + 3072);
      x2 = *reinterpret_cast<const float2*>(sc0 + 2 * 3072);
      unsigned ur[4];
#pragma unroll
      for (int i = 0; i < 4; ++i) ur[i] = *reinterpret_cast<const unsigned*>(P1 + (size_t)(base + i) * 3072 + col);
#pragma unroll
      for (int i = 0; i < 4; ++i) {
        unsigned u3 = ur[i];
        float2 x3 = {bflo(u3), bfhi(u3)};
        float oa = x0.x * w0.x + x1.x * w1.x + x2.x * w2.x + x3.x * w3.x;
        float ob = x0.y * w0.y + x1.y * w1.y + x2.y * w2.y + x3.y * w3.y;
        oa = siluf_(oa); ob = siluf_(ob);
        if (ten < 2) {
          float ss = wave_sum(oa * oa + ob * ob);
          float sc = rsqrtf(ss + EPS);
          if (ten == 0) sc *= 0.08838834764831845f;
          oa *= sc; ob *= sc;
        }
        *reinterpret_cast<unsigned*>(tokmaj + (size_t)(base + i) * 1024 + hh * 128 + lane * 2) = pk2(oa, ob);
        if (i >= 1)
          *reinterpret_cast<float2*>(p.out + O_CONVS + ((size_t)(l * 128 + b) * 3 + (i - 1)) * 3072 + col) = x3;
        x0 = x1; x1 = x2; x2 = x3;
      }
    }
  }
  const int col = tid * 4;
  const int win = 2 << wave;
  if (mode & 2)
  for (int bt = blockIdx.x; bt < 64 + 512; bt += gridDim.x) {
    if (bt < 64) {
      for (int i = 0; i < 8; ++i) {
        const int tt = TP + bt * 8 + i;
        const int sb = (tt - TP) >> 2, t = (tt - TP) & 3;
        const float* sp = p.state_pool + ((size_t)(l * 128 + sb) * 15) * 1024 + col;
        float s0 = 0.f, s1 = 0.f, s2 = 0.f, s3 = 0.f;
        float4 ut = {0.f, 0.f, 0.f, 0.f};
#pragma unroll
        for (int k = 0; k < 16; ++k) {
          if (k < win) {
            const int ti = t - k;
            float a0, a1, a2, a3;
            if (ti >= 0) {
              uint2 u = *reinterpret_cast<const uint2*>(Ub + (size_t)(tt - k) * 1024 + col);
              a0 = bflo(u.x); a1 = bfhi(u.x); a2 = bflo(u.y); a3 = bfhi(u.y);
            } else {
              float4 hh = *reinterpret_cast<const float4*>(sp + (size_t)(15 + ti) * 1024);
              a0 = hh.x; a1 = hh.y; a2 = hh.z; a3 = hh.w;
            }
            if (k == 0) ut = {a0, a1, a2, a3};
            s0 += a0; s1 += a1; s2 += a2; s3 += a3;
          }
        }
        float* po = p.out + O_POOLS + ((size_t)(l * 128 + sb) * 15) * 1024 + col;
        *reinterpret_cast<float4*>(po + (size_t)(11 + t) * 1024) = ut;
        if (t == 0) {
#pragma unroll
          for (int r = 0; r < 11; ++r)
            *reinterpret_cast<float4*>(po + (size_t)r * 1024) = *reinterpret_cast<const float4*>(sp + (size_t)(r + 4) * 1024);
        }
        const float inv = 1.f / (float)win;
        store_bf4(ypre + (size_t)tt * 1024 + col, s0 * inv - ut.x, s1 * inv - ut.y, s2 * inv - ut.z, s3 * inv - ut.w);
      }
    } else {
      const int tb = (bt - 64) * 32;
      const int b = tb >> 11, t0 = tb & 2047;
      float s0 = 0.f, s1 = 0.f, s2 = 0.f, s3 = 0.f;
#pragma unroll
      for (int k = 1; k < 16; ++k) {
        if (k < win && t0 - k >= 0) {
          uint2 u = *reinterpret_cast<const uint2*>(Ub + (size_t)(tb - k) * 1024 + col);
          s0 += bflo(u.x); s1 += bfhi(u.x); s2 += bflo(u.y); s3 += bfhi(u.y);
        }
      }
      for (int c8 = 0; c8 < 32; c8 += 8) {
        uint2 un[8], uo[8];
#pragma unroll
        for (int i = 0; i < 8; ++i) {
          un[i] = *reinterpret_cast<const uint2*>(Ub + (size_t)(tb + c8 + i) * 1024 + col);
          const int told = t0 + c8 + i - win + 1;
          uo[i] = told >= 0 ? *reinterpret_cast<const uint2*>(Ub + (size_t)(tb + c8 + i - win + 1) * 1024 + col) : uint2{0u, 0u};
        }
#pragma unroll
        for (int i = 0; i < 8; ++i) {
          const int t = t0 + c8 + i;
          const float a0 = bflo(un[i].x), a1 = bfhi(un[i].x), a2 = bflo(un[i].y), a3 = bfhi(un[i].y);
          s0 += a0; s1 += a1; s2 += a2; s3 += a3;
          const float inv = frcp_((float)min(t + 1, win));
          store_bf4(ypre + (size_t)(tb + c8 + i) * 1024 + col, s0 * inv - a0, s1 * inv - a1, s2 * inv - a2, s3 * inv - a3);
          if (t >= 2033)
            *reinterpret_cast<float4*>(p.out + O_POOLP + ((size_t)(l * 8 + b) * 15 + (t - 2033)) * 1024 + col) = float4{a0, a1, a2, a3};
          s0 -= bflo(uo[i].x); s1 -= bfhi(uo[i].x); s2 -= bflo(uo[i].y); s3 -= bfhi(uo[i].y);
        }
      }
    }
  }
}

__device__ void scan_task(const Params& p, int l, int seq, int h, int vgb, char* smem, int tid) {
  const int lane = tid & 63, wave = __builtin_amdgcn_readfirstlane(tid >> 6), v = lane & 15, kq = lane >> 4;
  const int vg = vgb + wave;
  const u16* Qa = reinterpret_cast<const u16*>(p.ws + OFF_QA);
  const u16* Ka = reinterpret_cast<const u16*>(p.ws + OFF_KA);
  const u16* Va = reinterpret_cast<const u16*>(p.ws + OFF_VA);
  const float* gbuf = reinterpret_cast<const float*>(p.ws + OFF_G);
  const float* bbuf = reinterpret_cast<const float*>(p.ws + OFF_BETA);
  u16* oraw = reinterpret_cast<u16*>(p.ws + OFF_ORAW);
  const int tok0 = TP + seq * 4;
  const int nT = 4;
  float S[32];
  float* sout;
  {
    const float* s0 = p.state_delta + (((size_t)(l * 128 + seq) * 8 + h) * 128 + kq * 32) * 128 + vg * 16 + v;
#pragma unroll
    for (int i = 0; i < 32; ++i) S[i] = s0[(size_t)i * 128];
    sout = p.out + O_DELTAS + (((size_t)(l * 128 + seq) * 8 + h) * 128 + kq * 32) * 128 + vg * 16 + v;
  }
  uint4 pre0, pre1, pre2, pre3, pre4;
  float pg = 0.f, pbeta = 0.f;
#define SCAN_LD1(J, VAR)                                                                                          \
  {                                                                                                               \
    const int pc = tid + 256 * (J);                                                                               \
    const int tk = pc / 40, w = pc % 40;                                                                          \
    const size_t ro = (size_t)(tok0 + c0_ + (tk < n_ ? tk : 0)) * 1024 + h * 128;                                 \
    const u16* src = w < 16 ? Ka + ro + w * 8 : w < 32 ? Qa + ro + (w - 16) * 8 : Va + ro + vgb * 16 + (w - 32) * 8; \
    VAR = *reinterpret_cast<const uint4*>(src);                                                                   \
  }
#define SCAN_PREFETCH(C0)                                                                                         \
  {                                                                                                               \
    const int c0_ = (C0);                                                                                         \
    const int n_ = min(32, nT - c0_);                                                                             \
    SCAN_LD1(0, pre0) SCAN_LD1(1, pre1) SCAN_LD1(2, pre2) SCAN_LD1(3, pre3) SCAN_LD1(4, pre4)                     \
    if (tid < 32) {                                                                                               \
      const int tk = tid < n_ ? tid : 0;                                                                          \
      pg = gbuf[(size_t)(tok0 + c0_ + tk) * 8 + h];                                                               \
      pbeta = bbuf[(size_t)(tok0 + c0_ + tk) * 8 + h];                                                            \
    }                                                                                                             \
  }
#define SCAN_ST1(J, VAR)                                                                                          \
  {                                                                                                               \
    const int pc = tid + 256 * (J);                                                                               \
    const int tk = pc / 40, w = pc % 40;                                                                          \
    if (tk < n) {                                                                                                 \
      const int dst = tk * 640 + (w < 16 ? w * 16 : w < 32 ? 256 + (w - 16) * 16 : 512 + (w - 32) * 16);          \
      *reinterpret_cast<uint4*>(smem + dst) = VAR;                                                                \
    }                                                                                                             \
  }
  SCAN_PREFETCH(0)
  for (int c0 = 0; c0 < nT; c0 += 32) {
    const int n = min(32, nT - c0);
    __syncthreads();
    SCAN_ST1(0, pre0) SCAN_ST1(1, pre1) SCAN_ST1(2, pre2) SCAN_ST1(3, pre3) SCAN_ST1(4, pre4)
    if (tid < 32) {
      *reinterpret_cast<float*>(smem + 20480 + tid * 4) = pg;
      *reinterpret_cast<float*>(smem + 20480 + 128 + tid * 4) = pbeta;
    }
    __syncthreads();
    if (c0 + 32 < nT) SCAN_PREFETCH(c0 + 32)
    for (int tt = 0; tt < n; ++tt) {
      const char* rowb = smem + tt * 640;
      uint4 kw[4], qw[4];
#pragma unroll
      for (int i = 0; i < 4; ++i) {
        kw[i] = *reinterpret_cast<const uint4*>(rowb + kq * 64 + i * 16);
        qw[i] = *reinterpret_cast<const uint4*>(rowb + 256 + kq * 64 + i * 16);
      }
      const float vv = __uint_as_float((unsigned)(*reinterpret_cast<const u16*>(rowb + 512 + (wave * 16 + v) * 2)) << 16);
      const float gv = *reinterpret_cast<const float*>(smem + 20480 + tt * 4);
      const float be = *reinterpret_cast<const float*>(smem + 20480 + 128 + tt * 4);
      const float a = __expf(gv);
      float kf[32];
#pragma unroll
      for (int i = 0; i < 4; ++i) {
        kf[i * 8 + 0] = bflo(kw[i].x); kf[i * 8 + 1] = bfhi(kw[i].x);
        kf[i * 8 + 2] = bflo(kw[i].y); kf[i * 8 + 3] = bfhi(kw[i].y);
        kf[i * 8 + 4] = bflo(kw[i].z); kf[i * 8 + 5] = bfhi(kw[i].z);
        kf[i * 8 + 6] = bflo(kw[i].w); kf[i * 8 + 7] = bfhi(kw[i].w);
      }
      float r0 = 0.f, r1 = 0.f;
#pragma unroll
      for (int i = 0; i < 32; i += 2) { r0 += kf[i] * S[i]; r1 += kf[i + 1] * S[i + 1]; }
      float r = r0 + r1;
      r += __shfl_xor(r, 16);
      r += __shfl_xor(r, 32);
      const float u = be * (vv - a * r);
#pragma unroll
      for (int i = 0; i < 32; ++i) S[i] = a * S[i] + kf[i] * u;
      float o0 = 0.f, o1 = 0.f;
#pragma unroll
      for (int i = 0; i < 4; ++i) {
        o0 += bflo(qw[i].x) * S[i * 8 + 0]; o1 += bfhi(qw[i].x) * S[i * 8 + 1];
        o0 += bflo(qw[i].y) * S[i * 8 + 2]; o1 += bfhi(qw[i].y) * S[i * 8 + 3];
        o0 += bflo(qw[i].z) * S[i * 8 + 4]; o1 += bfhi(qw[i].z) * S[i * 8 + 5];
        o0 += bflo(qw[i].w) * S[i * 8 + 6]; o1 += bfhi(qw[i].w) * S[i * 8 + 7];
      }
      float o = o0 + o1;
      o += __shfl_xor(o, 16);
      o += __shfl_xor(o, 32);
      if (kq == 0) oraw[(size_t)(tok0 + c0 + tt) * 1024 + h * 128 + vg * 16 + v] = (u16)(pk2(o, o) & 0xffffu);
    }
  }
#pragma unroll
  for (int i = 0; i < 32; ++i) sout[(size_t)i * 128] = S[i];
}

__device__ void pool_gemm_tile(const Params& p, int l, int tl, char* smem, int tid) {
  const int mt = tl >> 3, r = tl & 7, g = r >> 1, nh = r & 1;
  const u16* ypre = reinterpret_cast<const u16*>(p.ws + OFF_Y);
  const u16* W = reinterpret_cast<const u16*>(p.ws + OFF_WPL) + (size_t)(l * 4 + g) * 256 * 256;
  const u16* GP = reinterpret_cast<const u16*>(p.ws + OFF_GP);
  u16* ybin = ybin_row(p.ws, (size_t)mt * 128) - (size_t)mt * 128 * 1024;
  f32x4 acc[4][4];
  acc_zero(acc);
  gemm_dma(ypre + (size_t)mt * 128 * 1024 + g * 256, W + (size_t)nh * 128 * 256, ypre + (size_t)mt * 128 * 1024 + g * 256, W + (size_t)nh * 128 * 256, 1024, 256, 256, true, acc, smem, tid);
  const int c0 = g * 256 + nh * 128;
  const float* psc = p.pool_scale + l * 1024 + c0;
  EPI_LOOP({
    const size_t t = (size_t)mt * 128 + row;
    float4 sc = *reinterpret_cast<const float4*>(psc + col);
    uint2 gp = *reinterpret_cast<const uint2*>(GP + t * 1024 + c0 + col);
    store_bf4(ybin + t * 1024 + c0 + col, v[0] * sc.x * siluf_(bflo(gp.x)), v[1] * sc.y * siluf_(bfhi(gp.x)),
              v[2] * sc.z * siluf_(bflo(gp.y)), v[3] * sc.w * siluf_(bfhi(gp.y)));
  })
}

DI bf16x8 frag_nat(const char* base, int stride, int row0, int kb, int lane) {
  return *reinterpret_cast<const bf16x8*>(base + (row0 + (lane & 15)) * stride + (kb * 32 + (lane >> 4) * 8) * 2);
}
DI bf16x8 frag_perm(const char* base, int stride, int row0, int kb, int lane) {
  const char* pp = base + (row0 + (lane & 15)) * stride + (kb * 32 + (lane >> 4) * 4) * 2;
  uint2 a = *reinterpret_cast<const uint2*>(pp);
  uint2 b = *reinterpret_cast<const uint2*>(pp + 32);
  uint4 u = {a.x, a.y, b.x, b.y};
  return __builtin_bit_cast(bf16x8, u);
}
DI bf16x8 pack_acc(const f32x4& a, const f32x4& b) {
  uint4 u = {pk2(a[0], a[1]), pk2(a[2], a[3]), pk2(b[0], b[1]), pk2(b[2], b[3])};
  return __builtin_bit_cast(bf16x8, u);
}
#define MFMA16(X, Y, C) __builtin_amdgcn_mfma_f32_16x16x32_bf16((X), (Y), (C), 0, 0, 0)
DI uint4 scale8(uint4 u, float s0, float s1, float s2, float s3, float s4, float s5, float s6, float s7) {
  uint4 r;
  r.x = pk2(bflo(u.x) * s0, bfhi(u.x) * s1);
  r.y = pk2(bflo(u.y) * s2, bfhi(u.y) * s3);
  r.z = pk2(bflo(u.z) * s4, bfhi(u.z) * s5);
  r.w = pk2(bflo(u.w) * s6, bfhi(u.w) * s7);
  return r;
}

template <int I, int G>
DI void solve_group(float (&t)[64], float& acc, const float* __restrict__ sA) {
  if constexpr (G * 32 < I) {
    float4 cur[8];
#pragma unroll
    for (int j4 = 0; j4 < 8; ++j4)
      if ((G * 8 + j4) * 4 < I) cur[j4] = *reinterpret_cast<const float4*>(sA + I * 68 + (G * 8 + j4) * 4);
    __builtin_amdgcn_sched_barrier(0);
#pragma unroll
    for (int j4 = 0; j4 < 8; ++j4) {
      constexpr int dummy = 0; (void)dummy;
      const int jb = (G * 8 + j4) * 4;
      if (jb < I) {
        const float4 a = cur[j4];
        if (jb + 0 < I) acc -= a.x * t[jb + 0];
        if (jb + 1 < I) acc -= a.y * t[jb + 1];
        if (jb + 2 < I) acc -= a.z * t[jb + 2];
        if (jb + 3 < I) acc -= a.w * t[jb + 3];
      }
    }
    __builtin_amdgcn_sched_barrier(0);
  }
}
template <int I>
DI void solve_rows(float (&t)[64], const float* __restrict__ sA, int lane) {
  if constexpr (I < 64) {
    float acc = (lane == I) ? 1.f : 0.f;
    solve_group<I, 0>(t, acc, sA);
    solve_group<I, 1>(t, acc, sA);
    t[I] = acc;
    solve_rows<I + 1>(t, sA, lane);
  }
}

__device__ void phase_chunk_prep(const Params& p, int l, char* smem, int tid) {
  const int lane = tid & 63, wave = __builtin_amdgcn_readfirstlane(tid >> 6), r16 = lane & 15, q4 = lane >> 4;
  char* sK = smem;
  char* sQ = smem + 17408;
  char* sKT = smem;
  char* sVT = smem + 18432;
  float* sA = reinterpret_cast<float*>(smem + 36864);
  char* sT = smem + 36864 + 17408;
  float* sG = reinterpret_cast<float*>(smem + 36864 + 17408 + 9216);
  float* sB = sG + 64;
  const u16* Qa = reinterpret_cast<const u16*>(p.ws + OFF_QA);
  const u16* Ka = reinterpret_cast<const u16*>(p.ws + OFF_KA);
  const u16* KT = reinterpret_cast<const u16*>(p.ws + OFF_KT);
  const u16* VT = reinterpret_cast<const u16*>(p.ws + OFF_VA);
  const float* gbuf = reinterpret_cast<const float*>(p.ws + OFF_G);
  const float* bbuf = reinterpret_cast<const float*>(p.ws + OFF_BETA);
  float* GL = reinterpret_cast<float*>(p.ws + OFF_GL);
  for (int cid = blockIdx.x; cid < 2048; cid += gridDim.x) {
    const int bh = cid >> 5, n = cid & 31, b = bh >> 3, h = bh & 7;
    const int tok0 = b * 2048 + n * 64;
    u16* img = reinterpret_cast<u16*>(p.ws + OFF_IMG + (size_t)cid * IMG_BYTES);
    u16* wvt = reinterpret_cast<u16*>(p.ws + OFF_WVT + (size_t)cid * 16384);
    __syncthreads();
    if (tid < 64) {
      float g = gbuf[(size_t)(tok0 + tid) * 8 + h];
#pragma unroll
      for (int o = 1; o < 64; o <<= 1) {
        float t = __shfl_up(g, o);
        if (lane >= o) g += t;
      }
      sG[tid] = g;
      sB[tid] = bbuf[(size_t)(tok0 + tid) * 8 + h];
    }
#pragma unroll
    for (int j = 0; j < 4; ++j) {
      const int pc = tid + 256 * j, row = pc >> 4, c16 = pc & 15;
      *reinterpret_cast<uint4*>(sK + row * 272 + c16 * 16) =
          *reinterpret_cast<const uint4*>(Ka + (size_t)(tok0 + row) * 1024 + h * 128 + c16 * 8);
      *reinterpret_cast<uint4*>(sQ + row * 272 + c16 * 16) =
          *reinterpret_cast<const uint4*>(Qa + (size_t)(tok0 + row) * 1024 + h * 128 + c16 * 8);
    }
    __syncthreads();
    {
      bf16x8 yk[4], yq[4];
#pragma unroll
      for (int kb = 0; kb < 4; ++kb) {
        yk[kb] = frag_nat(sK, 272, wave * 16, kb, lane);
        yq[kb] = frag_nat(sQ, 272, wave * 16, kb, lane);
      }
      const int jy = wave * 16 + r16;
      const float Gy = sG[jy];
#pragma unroll
      for (int it = 0; it < 4; ++it) {
        f32x4 akk = {0.f, 0.f, 0.f, 0.f}, aqk = {0.f, 0.f, 0.f, 0.f};
#pragma unroll
        for (int kb = 0; kb < 4; ++kb) {
          bf16x8 xk = frag_nat(sK, 272, it * 16, kb, lane);
          akk = MFMA16(xk, yk[kb], akk);
          aqk = MFMA16(xk, yq[kb], aqk);
        }
        float wq[4];
#pragma unroll
        for (int e = 0; e < 4; ++e) {
          const int i = it * 16 + q4 * 4 + e;
          const float Gi = sG[i];
          sA[i * 68 + jy] = (i > jy) ? sB[i] * akk[e] * __expf(Gi - Gy) : 0.f;
          wq[e] = (jy >= i) ? aqk[e] * __expf(Gy - Gi) : 0.f;
        }
        store_bf4(img + 16384 + jy * 64 + it * 16 + q4 * 4, wq[0], wq[1], wq[2], wq[3]);
      }
    }
    __syncthreads();
    if (wave == 0) {
      float t[64];
      solve_rows<0>(t, sA, lane);
#pragma unroll
      for (int i = 0; i < 64; ++i) *reinterpret_cast<u16*>(sT + i * 144 + lane * 2) = (u16)(pk2(t[i], t[i]) & 0xffffu);
    } else {
      const float Glast = sG[63];
      if (tid == 64) GL[cid] = __expf(Glast);
#pragma unroll 1
      for (int pc = tid - 64; pc < 1024; pc += 192) {
        const int c = pc >> 3, i8 = pc & 7;
        uint4 uk = *reinterpret_cast<const uint4*>(KT + ((size_t)bh * 128 + c) * 2048 + n * 64 + i8 * 8);
        uint4 uv = *reinterpret_cast<const uint4*>(VT + ((size_t)bh * 128 + c) * 2048 + n * 64 + i8 * 8);
        const float* gp = sG + i8 * 8;
        const float* bp = sB + i8 * 8;
        *reinterpret_cast<uint4*>(sKT + c * 144 + i8 * 16) =
            scale8(uk, bp[0] * __expf(gp[0]), bp[1] * __expf(gp[1]), bp[2] * __expf(gp[2]), bp[3] * __expf(gp[3]),
                   bp[4] * __expf(gp[4]), bp[5] * __expf(gp[5]), bp[6] * __expf(gp[6]), bp[7] * __expf(gp[7]));
        *reinterpret_cast<uint4*>(sVT + c * 144 + i8 * 16) = scale8(uv, bp[0], bp[1], bp[2], bp[3], bp[4], bp[5], bp[6], bp[7]);
        *reinterpret_cast<uint4*>(img + 20480 + c * 64 + i8 * 8) =
            scale8(uk, __expf(Glast - gp[0]), __expf(Glast - gp[1]), __expf(Glast - gp[2]), __expf(Glast - gp[3]),
                   __expf(Glast - gp[4]), __expf(Glast - gp[5]), __expf(Glast - gp[6]), __expf(Glast - gp[7]));
      }
#pragma unroll 1
      for (int pc = tid - 64; pc < 1024; pc += 192) {
        const int i = pc >> 4, c16 = pc & 15;
        uint4 u = *reinterpret_cast<const uint4*>(Qa + (size_t)(tok0 + i) * 1024 + h * 128 + c16 * 8);
        const float sc = __expf(sG[i]);
        *reinterpret_cast<uint4*>(img + 8192 + i * 128 + c16 * 8) = scale8(u, sc, sc, sc, sc, sc, sc, sc, sc);
      }
    }
    __syncthreads();
    {
      bf16x8 yt[2];
#pragma unroll
      for (int kb = 0; kb < 2; ++kb) yt[kb] = frag_nat(sT, 144, wave * 16, kb, lane);
      const int iy = wave * 16 + r16;
#pragma unroll
      for (int ct = 0; ct < 8; ++ct) {
        f32x4 a = {0.f, 0.f, 0.f, 0.f};
#pragma unroll
        for (int kb = 0; kb < 2; ++kb) a = MFMA16(frag_nat(sKT, 144, ct * 16, kb, lane), yt[kb], a);
        store_bf4(img + iy * 128 + ct * 16 + q4 * 4, -a[0], -a[1], -a[2], -a[3]);
      }
#pragma unroll
      for (int v2 = 0; v2 < 2; ++v2) {
        const int vt = wave * 2 + v2;
        bf16x8 yv[2];
#pragma unroll
        for (int kb = 0; kb < 2; ++kb) yv[kb] = frag_nat(sVT, 144, vt * 16, kb, lane);
#pragma unroll
        for (int it = 0; it < 4; ++it) {
          f32x4 a = {0.f, 0.f, 0.f, 0.f};
#pragma unroll
          for (int kb = 0; kb < 2; ++kb) a = MFMA16(frag_nat(sT, 144, it * 16, kb, lane), yv[kb], a);
          store_bf4(wvt + (vt * 16 + r16) * 64 + it * 16 + q4 * 4, a[0], a[1], a[2], a[3]);
        }
      }
    }
  }
}

#define PRE_LIST(X) X(0) X(1) X(2) X(3) X(4) X(5) X(6) X(7) X(8) X(9) X(10) X(11) X(12) X(13)
__device__ void chunk_scan_task(const Params& p, int l, int bh, int vhalf, char* smem, int tid) {
  const int lane = tid & 63, wave = __builtin_amdgcn_readfirstlane(tid >> 6), r16 = lane & 15, q4 = lane >> 4;
  const int b = bh >> 3, h = bh & 7;
  const int v0 = vhalf * 64 + wave * 16;
  const char* img0 = p.ws + OFF_IMG + (size_t)(bh * 32) * IMG_BYTES;
  const u16* wvt0 = reinterpret_cast<const u16*>(p.ws + OFF_WVT + (size_t)(bh * 32) * 16384);
  const float* GL = reinterpret_cast<const float*>(p.ws + OFF_GL) + bh * 32;
  u16* oraw = reinterpret_cast<u16*>(p.ws + OFF_ORAW);
  char* sWk = smem;
  char* sQd = smem + 17408;
  char* sQK = smem + 34816;
  char* sKtT = smem + 44032;
  f32x4 S[8];
#pragma unroll
  for (int i = 0; i < 8; ++i) S[i] = f32x4{0.f, 0.f, 0.f, 0.f};
#define PRE_DECL(J) uint4 pre##J;
  PRE_LIST(PRE_DECL)
  uint2 wv0, wv1, wv2, wv3;
  float gln;
#define PRE_LOAD(J) pre##J = *reinterpret_cast<const uint4*>(imgn + J * 4096 + voff);
#define SCAN_FETCH(N)                                                                                   \
  {                                                                                                     \
    const char* imgn = img0 + (size_t)(N) * IMG_BYTES;                                                  \
    PRE_LIST(PRE_LOAD)                                                                                  \
    const u16* wp = wvt0 + (size_t)(N) * 8192 + wvoff;                                                  \
    wv0 = *reinterpret_cast<const uint2*>(wp);                                                          \
    wv1 = *reinterpret_cast<const uint2*>(wp + 16);                                                     \
    wv2 = *reinterpret_cast<const uint2*>(wp + 32);                                                     \
    wv3 = *reinterpret_cast<const uint2*>(wp + 48);                                                     \
    gln = GL[N];                                                                                        \
  }
#define PRE_STORE(J)                                                                                    \
  {                                                                                                     \
    const int pc = tid + 256 * J;                                                                       \
    int off;                                                                                            \
    if (J < 4) off = (pc >> 4) * 272 + (pc & 15) * 16;                                                  \
    else if (J < 8) off = 17408 + ((pc - 1024) >> 4) * 272 + (pc & 15) * 16;                            \
    else if (J < 10) off = 34816 + ((pc - 2048) >> 3) * 144 + (pc & 7) * 16;                            \
    else off = 44032 + ((pc - 2560) >> 3) * 144 + (pc & 7) * 16;                                        \
    *reinterpret_cast<uint4*>(smem + off) = pre##J;                                                     \
  }
  const unsigned voff = (unsigned)tid * 16u;
  const unsigned wvoff = (unsigned)((v0 + r16) * 64 + q4 * 4);
  SCAN_FETCH(0)
  for (int n = 0; n < 32; ++n) {
    __syncthreads();
    PRE_LIST(PRE_STORE)
    __syncthreads();
    const uint2 c0 = wv0, c1 = wv1, c2 = wv2, c3 = wv3;
    const float gl = gln;
    if (n + 1 < 32) SCAN_FETCH(n + 1)
    bf16x8 Sop[4];
#pragma unroll
    for (int kb = 0; kb < 4; ++kb) Sop[kb] = pack_acc(S[2 * kb], S[2 * kb + 1]);
    f32x4 U[4];
    U[0] = f32x4{bflo(c0.x), bfhi(c0.x), bflo(c0.y), bfhi(c0.y)};
    U[1] = f32x4{bflo(c1.x), bfhi(c1.x), bflo(c1.y), bfhi(c1.y)};
    U[2] = f32x4{bflo(c2.x), bfhi(c2.x), bflo(c2.y), bfhi(c2.y)};
    U[3] = f32x4{bflo(c3.x), bfhi(c3.x), bflo(c3.y), bfhi(c3.y)};
#pragma unroll
    for (int it = 0; it < 4; ++it) {
#pragma unroll
      for (int kb = 0; kb < 4; ++kb) U[it] = MFMA16(frag_perm(sWk, 272, it * 16, kb, lane), Sop[kb], U[it]);
    }
    bf16x8 Uop[2];
    Uop[0] = pack_acc(U[0], U[1]);
    Uop[1] = pack_acc(U[2], U[3]);
    const size_t tokb = (size_t)b * 2048 + n * 64;
    const unsigned olane = (unsigned)(q4 * 4 * 1024 + v0 + r16);
#pragma unroll
    for (int it = 0; it < 4; ++it) {
      f32x4 O = {0.f, 0.f, 0.f, 0.f};
#pragma unroll
      for (int kb = 0; kb < 4; ++kb) O = MFMA16(frag_perm(sQd, 272, it * 16, kb, lane), Sop[kb], O);
#pragma unroll
      for (int jb = 0; jb < 2; ++jb) O = MFMA16(frag_perm(sQK, 144, it * 16, jb, lane), Uop[jb], O);
#pragma unroll
      for (int e = 0; e < 4; ++e) {
        u16* pst = oraw + (tokb + it * 16 + e) * 1024 + h * 128;
        pst[olane] = (u16)(pk2(O[e], O[e]) & 0xffffu);
      }
    }
#pragma unroll
    for (int kt = 0; kt < 8; ++kt) {
      f32x4 a = S[kt];
      a[0] *= gl; a[1] *= gl; a[2] *= gl; a[3] *= gl;
#pragma unroll
      for (int jb = 0; jb < 2; ++jb) a = MFMA16(frag_perm(sKtT, 144, kt * 16, jb, lane), Uop[jb], a);
      S[kt] = a;
    }
  }
  float* sout = p.out + O_DELTAP + ((size_t)(l * 8 + b) * 8 + h) * 128 * 128 + v0 + r16;
#pragma unroll
  for (int kt = 0; kt < 8; ++kt)
#pragma unroll
    for (int e = 0; e < 4; ++e) sout[(size_t)(kt * 16 + q4 * 4 + e) * 128] = S[kt][e];
}

__device__ void pp_gemm_tile(const Params& p, int l, int tl, char* smem, int tid) {
  const int mt = tl >> 3, nt = tl & 7;
  const u16* pb = reinterpret_cast<const u16*>(p.ws + OFF_PB);
  const u16* Wp = reinterpret_cast<const u16*>(p.ws + OFF_WP) + (size_t)l * 1024 * 256;
  u16* pp = pp_row(p.ws, (size_t)mt * 128) - (size_t)mt * 128 * 1024;
  f32x4 acc[4][4];
  acc_zero(acc);
  gemm_dma(pb + (size_t)mt * 128 * 256, Wp + (size_t)nt * 128 * 256, pb + (size_t)mt * 128 * 256, Wp + (size_t)nt * 128 * 256, 256, 256, 256, true, acc, smem, tid);
  EPI_LOOP({
    const size_t t = (size_t)mt * 128 + row;
    store_bf4(pp + t * 1024 + nt * 128 + col, v[0], v[1], v[2], v[3]);
  })
}

__device__ void phase_scan(const Params& p, int l, char* smem, int tid, int cidx = 0) {
  unsigned* cnt = reinterpret_cast<unsigned*>(p.ws + OFF_CNT) + l + cidx;
  int* s_item = reinterpret_cast<int*>(smem + 65024);
  const int n_items = 128 + 2048 + 1056 + 1056;
  while (true) {
    __syncthreads();
    if (tid == 0) *s_item = (int)atomicAdd(cnt, 1u);
    __syncthreads();
    int it = *s_item;
    if (it >= n_items) break;
    it = __builtin_amdgcn_readfirstlane(it);
    int tq = tid;
    asm volatile("" : "+v"(tq));
    if (it < 128) {
      chunk_scan_task(p, l, it >> 1, it & 1, smem, tq);
    } else if (it < 128 + 2048) {
      const int wt = (it - 128) * 4;
      scan_task(p, l, wt >> 6, (wt >> 3) & 7, wt & 7, smem, tq);
    } else if (it < 128 + 2048 + 1056) {
      pool_gemm_tile(p, l, it - 2176, smem, tq);
    } else {
      pp_gemm_tile(p, l, it - 3232, smem, tq);
    }
  }
}

__device__ void phase_onorm(const Params& p, int l, int tid) {
  const int lane = tid & 63, wave = __builtin_amdgcn_readfirstlane(tid >> 6);
  const u16* oraw = reinterpret_cast<const u16*>(p.ws + OFF_ORAW);
  const u16* Zb = reinterpret_cast<const u16*>(p.ws + OFF_Z);
  u16* og = reinterpret_cast<u16*>(p.ws + OFF_OG);
  float gn[16];
#pragma unroll
  for (int i = 0; i < 4; ++i) {
    float4 w = *reinterpret_cast<const float4*>(p.gdn_norm + l * 128 + (lane & 7) * 16 + i * 4);
    gn[i * 4] = w.x; gn[i * 4 + 1] = w.y; gn[i * 4 + 2] = w.z; gn[i * 4 + 3] = w.w;
  }
  for (int r = blockIdx.x * 4 + wave; r < T; r += gridDim.x * 4) {
    uint4 o0 = *reinterpret_cast<const uint4*>(oraw + (size_t)r * 1024 + lane * 16);
    uint4 o1 = *reinterpret_cast<const uint4*>(oraw + (size_t)r * 1024 + lane * 16 + 8);
    uint4 z0 = *reinterpret_cast<const uint4*>(Zb + (size_t)r * 1024 + lane * 16);
    uint4 z1 = *reinterpret_cast<const uint4*>(Zb + (size_t)r * 1024 + lane * 16 + 8);
    float o[16], z[16];
    o[0] = bflo(o0.x); o[1] = bfhi(o0.x); o[2] = bflo(o0.y); o[3] = bfhi(o0.y);
    o[4] = bflo(o0.z); o[5] = bfhi(o0.z); o[6] = bflo(o0.w); o[7] = bfhi(o0.w);
    o[8] = bflo(o1.x); o[9] = bfhi(o1.x); o[10] = bflo(o1.y); o[11] = bfhi(o1.y);
    o[12] = bflo(o1.z); o[13] = bfhi(o1.z); o[14] = bflo(o1.w); o[15] = bfhi(o1.w);
    z[0] = bflo(z0.x); z[1] = bfhi(z0.x); z[2] = bflo(z0.y); z[3] = bfhi(z0.y);
    z[4] = bflo(z0.z); z[5] = bfhi(z0.z); z[6] = bflo(z0.w); z[7] = bfhi(z0.w);
    z[8] = bflo(z1.x); z[9] = bfhi(z1.x); z[10] = bflo(z1.y); z[11] = bfhi(z1.y);
    z[12] = bflo(z1.z); z[13] = bfhi(z1.z); z[14] = bflo(z1.w); z[15] = bfhi(z1.w);
    float ss = 0.f;
#pragma unroll
    for (int i = 0; i < 16; ++i) ss += o[i] * o[i];
    ss += __shfl_xor(ss, 1);
    ss += __shfl_xor(ss, 2);
    ss += __shfl_xor(ss, 4);
    const float rstd = rsqrtf(ss * (1.f / 128.f) + EPS);
    float y[16];
#pragma unroll
    for (int i = 0; i < 16; ++i) y[i] = o[i] * rstd * gn[i] * siluf_(z[i]);
    uint4 w0, w1;
    w0.x = pk2(y[0], y[1]); w0.y = pk2(y[2], y[3]); w0.z = pk2(y[4], y[5]); w0.w = pk2(y[6], y[7]);
    w1.x = pk2(y[8], y[9]); w1.y = pk2(y[10], y[11]); w1.z = pk2(y[12], y[13]); w1.w = pk2(y[14], y[15]);
    *reinterpret_cast<uint4*>(og + (size_t)r * 1024 + lane * 16) = w0;
    *reinterpret_cast<uint4*>(og + (size_t)r * 1024 + lane * 16 + 8) = w1;
  }
}

__device__ void phase_merge(const Params& p, int l, char* smem, int tid) {
  const u16* og = reinterpret_cast<const u16*>(p.ws + OFF_OG);
  const u16* Wa = reinterpret_cast<const u16*>(p.ws + OFF_WA) + (size_t)l * 1024 * 1024;
  const u16* Wb = reinterpret_cast<const u16*>(p.ws + OFF_WB) + (size_t)l * 1024 * 1024;
  const u16* GA = reinterpret_cast<const u16*>(p.ws + OFF_GA);
  const u16* GB = reinterpret_cast<const u16*>(p.ws + OFF_GB);
  u16* mbuf = reinterpret_cast<u16*>(p.ws + OFF_M);
  XCD_TILE_LOOP(mt, nt) {
    f32x4 acc[4][4];
    acc_zero(acc);
    gemm_dma(og + (size_t)mt * 128 * 1024, Wa + (size_t)nt * 128 * 1024, og + (size_t)mt * 128 * 1024, Wa + (size_t)nt * 128 * 1024, 1024, 1024, 1024, true, acc, smem, tid);
    EPI_LOOP({
      const size_t t = (size_t)mt * 128 + row;
      uint2 ga = *reinterpret_cast<const uint2*>(GA + t * 1024 + nt * 128 + col);
      uint2 gb = *reinterpret_cast<const uint2*>(GB + t * 1024 + nt * 128 + col);
      v[0] *= (1.f + __expf(-bflo(gb.x))) * frcp_(1.f + __expf(-bflo(ga.x)));
      v[1] *= (1.f + __expf(-bfhi(gb.x))) * frcp_(1.f + __expf(-bfhi(ga.x)));
      v[2] *= (1.f + __expf(-bflo(gb.y))) * frcp_(1.f + __expf(-bflo(ga.y)));
      v[3] *= (1.f + __expf(-bfhi(gb.y))) * frcp_(1.f + __expf(-bfhi(ga.y)));
    })
    gemm_dma(ybin_row(p.ws, (size_t)mt * 128), Wb + (size_t)nt * 128 * 1024, ybin_row(p.ws, (size_t)mt * 128), Wb + (size_t)nt * 128 * 1024, 1024, 1024, 1024, true, acc, smem, tid);
    EPI_LOOP({
      const size_t t = (size_t)mt * 128 + row;
      uint2 gb = *reinterpret_cast<const uint2*>(GB + t * 1024 + nt * 128 + col);
      store_bf4(mbuf + t * 1024 + nt * 128 + col, v[0] * sigmoidf_(bflo(gb.x)), v[1] * sigmoidf_(bfhi(gb.x)),
                v[2] * sigmoidf_(bflo(gb.y)), v[3] * sigmoidf_(bfhi(gb.y)));
    })
  }
}

__device__ void phase_out(const Params& p, int l, char* smem, int tid) {
  const u16* mbuf = reinterpret_cast<const u16*>(p.ws + OFF_M);
  const u16* Wo = reinterpret_cast<const u16*>(p.ws + OFF_WO) + (size_t)l * 1024 * 1024;
  u16* x1b = reinterpret_cast<u16*>(p.ws + OFF_Y);
  float* ssq = reinterpret_cast<float*>(p.ws + OFF_SSQ);
  GREGS_DECL;
  bool first = true;
  XCD_TILE_LOOP_N(mt, nt, mtn, ntn) {
    f32x4 acc[4][4];
    acc_zero(acc);
    {
      gemm_dma(mbuf + (size_t)mt * 128 * 1024, Wo + (size_t)nt * 128 * 1024, mbuf + (size_t)mtn * 128 * 1024,
                  Wo + (size_t)ntn * 128 * 1024, 1024, 1024, 1024, first, acc, smem, tid);
      first = false;
      const int lane_ = tid & 63, wave_ = __builtin_amdgcn_readfirstlane(tid >> 6), wm_ = wave_ >> 1, wn_ = wave_ & 1;
#pragma unroll
      for (int m = 0; m < 4; ++m) {
        const int row = wm_ * 64 + m * 16 + (lane_ & 15);
        const size_t t = (size_t)mt * 128 + row;
        const float* xin = (l == 0) ? (t < TP ? p.x_prompt + t * 1024 : p.x_sample + (t - TP) * 1024) : p.out + t * 1024;
        float ss = 0.f;
#pragma unroll
        for (int n = 0; n < 4; ++n) {
          const int col = nt * 128 + wn_ * 64 + n * 16 + (lane_ >> 4) * 4;
          float4 xi = *reinterpret_cast<const float4*>(xin + col);
          float4 o;
          o.x = xi.x + acc[m][n][0]; o.y = xi.y + acc[m][n][1]; o.z = xi.z + acc[m][n][2]; o.w = xi.w + acc[m][n][3];
          *reinterpret_cast<float4*>(p.out + t * 1024 + col) = o;
          store_bf4(x1b + t * 1024 + col, o.x, o.y, o.z, o.w);
          ss += o.x * o.x + o.y * o.y + o.z * o.z + o.w * o.w;
        }
        ss += __shfl_xor(ss, 16);
        ss += __shfl_xor(ss, 32);
        if ((lane_ >> 4) == 0) ssq[t * 16 + nt * 2 + wn_] = ss;
      }
    }
  }
}

__device__ void phase_gate(const Params& p, int l, char* smem, int tid) {
  const u16* x1b = reinterpret_cast<const u16*>(p.ws + OFF_Y);
  const u16* Wg = reinterpret_cast<const u16*>(p.ws + OFF_WG) + (size_t)l * 1024 * 1024;
  const float* ssq = reinterpret_cast<const float*>(p.ws + OFF_SSQ);
  GREGS_DECL;
  bool first = true;
  XCD_TILE_LOOP_N(mt, nt, mtn, ntn) {
    f32x4 acc[4][4];
    acc_zero(acc);
    gemm_dma(x1b + (size_t)mt * 128 * 1024, Wg + (size_t)nt * 128 * 1024, x1b + (size_t)mtn * 128 * 1024,
                Wg + (size_t)ntn * 128 * 1024, 1024, 1024, 1024, first, acc, smem, tid);
    first = false;
    const int lane_ = tid & 63, wave_ = __builtin_amdgcn_readfirstlane(tid >> 6), wm_ = wave_ >> 1, wn_ = wave_ & 1;
#pragma unroll
    for (int m = 0; m < 4; ++m) {
      const int row = wm_ * 64 + m * 16 + (lane_ & 15);
      const size_t t = (size_t)mt * 128 + row;
      float ss = 0.f;
#pragma unroll
      for (int i = 0; i < 4; ++i) {
        float4 s4 = *reinterpret_cast<const float4*>(ssq + t * 16 + i * 4);
        ss += s4.x + s4.y + s4.z + s4.w;
      }
      const float rstd = rsqrtf(ss * (1.f / 1024.f) + EPS);
#pragma unroll
      for (int n = 0; n < 4; ++n) {
        const int col = nt * 128 + wn_ * 64 + n * 16 + (lane_ >> 4) * 4;
        float4 xi = *reinterpret_cast<const float4*>(p.out + t * 1024 + col);
        uint2 pv = *reinterpret_cast<const uint2*>(pp_row(p.ws, t) + col);
        float4 o;
        o.x = xi.x + sigmoidf_(rstd * acc[m][n][0]) * bflo(pv.x);
        o.y = xi.y + sigmoidf_(rstd * acc[m][n][1]) * bfhi(pv.x);
        o.z = xi.z + sigmoidf_(rstd * acc[m][n][2]) * bflo(pv.y);
        o.w = xi.w + sigmoidf_(rstd * acc[m][n][3]) * bfhi(pv.y);
        *reinterpret_cast<float4*>(p.out + t * 1024 + col) = o;
      }
    }
  }
}

__global__ void __launch_bounds__(NT, 2) fwd_megakernel(Params p) {
  __shared__ __attribute__((aligned(16))) char smem[65536];
  cg::grid_group grid = cg::this_grid();
  __shared__ uint4 xb_words;
  if (threadIdx.x == 0) xb_words = make_uint4(0u, 0u, 0u, 0u);
  __syncthreads();
  XcdBarrier xb = xcd_barrier_post(reinterpret_cast<unsigned*>(p.ws + OFF_BAR), (volatile LAS unsigned*)&xb_words);
  if (p.ph_hi > 1000) grid.sync();
  for (int ph = p.ph_lo; ph < p.ph_hi; ++ph) {
    if (ph > p.ph_lo) xcd_barrier(xb);
    int tid = threadIdx.x;
    asm volatile("" : "+v"(tid));
    if (ph == 18) { phase_final(p, tid); continue; }
    const int l = ph / 9, kind = ph % 9;
    switch (kind) {
      case 0:
        if (l == 0) {
          phase_convert_weights(p, smem, tid);
        }
        phase_prep(p, l, smem, tid);
        break;
      case 1: phase_inproj(p, l, smem, tid); if (REPEAT_KIND == 1) phase_inproj(p, l, smem, tid); break;
      case 2: phase_conv_pool(p, l, smem, tid); if (REPEAT_KIND == 20) phase_conv_pool(p, l, smem, tid, 1); if (REPEAT_KIND == 21) phase_conv_pool(p, l, smem, tid, 2); break;
      case 3: phase_chunk_prep(p, l, smem, tid); if (REPEAT_KIND == 3) phase_chunk_prep(p, l, smem, tid); break;
      case 4: phase_scan(p, l, smem, tid); if (REPEAT_KIND == 4) phase_scan(p, l, smem, tid, 2); break;
      case 5:
        phase_onorm(p, l, tid);
        break;
      case 6: phase_merge(p, l, smem, tid); if (REPEAT_KIND == 6) phase_merge(p, l, smem, tid); break;
      case 7: phase_out(p, l, smem, tid); break;
      case 8: phase_gate(p, l, smem, tid); break;
    }
  }
}

extern "C" void kernel_launch(void* const* d_in, const int* in_sizes, int n_in, void* d_out, int out_size, void* d_ws,
                              size_t ws_size, hipStream_t stream) {
  static int grid_blocks = 0;
  if (!grid_blocks) {
    int dev = 0, cus = 0, per_cu = 0;
    hipGetDevice(&dev);
    hipDeviceGetAttribute(&cus, hipDeviceAttributeMultiprocessorCount, dev);
    hipOccupancyMaxActiveBlocksPerMultiprocessor(&per_cu, fwd_megakernel, NT, 0);
    if (per_cu > 2) per_cu = 2;
    if (per_cu < 1) per_cu = 1;
    grid_blocks = cus * per_cu;
  }
  Params p{};
  const float** pp = reinterpret_cast<const float**>(&p);
  for (int i = 0; i < 22; ++i) pp[i] = reinterpret_cast<const float*>(d_in[i]);
  p.out = reinterpret_cast<float*>(d_out);
  p.ws = reinterpret_cast<char*>(d_ws);
  if (ws_size < WS_TOTAL) { fprintf(stderr, "workspace too small: %zu < %zu\n", ws_size, (size_t)WS_TOTAL); return; }
  hipMemsetAsync(p.ws + OFF_BAR, 0, ZERO_BYTES, stream);
#if ONE_LAUNCH
  p.ph_lo = 0; p.ph_hi = 19;
  void* args[] = {&p};
  hipError_t e = hipLaunchCooperativeKernel((void*)fwd_megakernel, dim3(grid_blocks), dim3(NT), args, 0, stream);
  if (e != hipSuccess) fprintf(stderr, "cooperative launch failed: %s (grid %d)\n", hipGetErrorString(e), grid_blocks);
#else
  for (int ph = 0; ph < 19; ++ph) {
    p.ph_lo = ph; p.ph_hi = ph + 1;
    fwd_megakernel<<<dim3(grid_blocks), dim3(NT), 0, stream>>>(p);
  }
#endif
}
```
